# Optimizing an MI355X kernel written in HIP

```python
import jax, jax.numpy as jnp
from jax import lax
import numpy as np

D_MODEL = 2048
BATCH = 32
SEQ = 256
DEPTH = 4
DEC_BATCH = 4
DEC_SEQ = 1024
PAST_LEN = 256

GRID_W = 64
HEAD_DIM = 128
ATTN_WIDTH = D_MODEL // 2
ATTN_HEADS = ATTN_WIDTH // HEAD_DIM
ATTN_KV_HEADS = ATTN_HEADS // 4
GQA_GROUP = ATTN_HEADS // ATTN_KV_HEADS
KV_WIDTH = ATTN_KV_HEADS * HEAD_DIM
GLA_VAL_WIDTH = D_MODEL - ATTN_WIDTH
GLA_KEY_WIDTH = GLA_VAL_WIDTH // 2
GLA_HEADS = 8
GLA_DK = GLA_KEY_WIDTH // GLA_HEADS
GLA_DV = GLA_VAL_WIDTH // GLA_HEADS
GLA_RANK = 16
GLA_TAU = 16.0
GLA_CHUNK = 64
D_FF = 4 * D_MODEL
Q_BLOCK = 128
ROPE_THETA = 10000.0
ROPE_AXIS_DIM = HEAD_DIM // 2
ROPE_FREQS = ROPE_AXIS_DIM // 2
N_MOD = 6
PROJ_WIDTH = ATTN_WIDTH + 2 * KV_WIDTH + 2 * GLA_KEY_WIDTH + 2 * GLA_VAL_WIDTH + 2 * GLA_RANK
EPS = 1e-6

kernel_name = 'hybrid_gqa_gla_prefix_diffusion_step'


def rmsnorm(x, g):
    xf = x.astype(jnp.float32)
    y = xf * lax.rsqrt(jnp.mean(jnp.square(xf), axis=-1, keepdims=True) + EPS)
    return (y * g.astype(jnp.float32)).astype(x.dtype)


def axial_rope_tables(n_tokens):
    rows = n_tokens // GRID_W
    r = jnp.repeat(jnp.arange(rows, dtype=jnp.float32), GRID_W)
    col = jnp.tile(jnp.arange(GRID_W, dtype=jnp.float32), rows)
    inv = ROPE_THETA ** (-jnp.arange(ROPE_FREQS, dtype=jnp.float32) / ROPE_FREQS)
    ang_r = r[:, None] * inv[None, :]
    ang_c = col[:, None] * inv[None, :]
    return (jnp.cos(ang_r), jnp.sin(ang_r), jnp.cos(ang_c), jnp.sin(ang_c))


def _rotate(x, cos, sin):
    x1, x2 = x[..., :ROPE_FREQS], x[..., ROPE_FREQS:]
    cos, sin = cos[None, :, None, :], sin[None, :, None, :]
    return jnp.concatenate([x1 * cos - x2 * sin, x2 * cos + x1 * sin], axis=-1)


def apply_axial_rope(x, rope):
    cos_r, sin_r, cos_c, sin_c = rope
    xf = x.astype(jnp.float32)
    out = jnp.concatenate([_rotate(xf[..., :ROPE_AXIS_DIM], cos_r, sin_r),
                           _rotate(xf[..., ROPE_AXIS_DIM:], cos_c, sin_c)], axis=-1)
    return out.astype(x.dtype)


def block_attention(q, k, v):
    B, T, H, Dh = q.shape
    nb = T // Q_BLOCK
    qb = q.reshape(B, nb, Q_BLOCK, ATTN_KV_HEADS, GQA_GROUP, Dh).transpose(1, 0, 2, 3, 4, 5)
    kf = k.astype(jnp.float32)
    vf = v.astype(jnp.float32)
    scale = Dh ** -0.5

    def one_block(qblk):
        s = jnp.einsum('bqkgd,bskd->bkgqs', qblk.astype(jnp.float32), kf) * scale
        p = jax.nn.softmax(s, axis=-1)
        o = jnp.einsum('bkgqs,bskd->bqkgd', p, vf)
        return o.reshape(B, Q_BLOCK, H * Dh).astype(q.dtype)

    out = lax.map(one_block, qb)
    return out.transpose(1, 0, 2, 3).reshape(B, T, H * Dh)


def _gla_chunk_step(state, blk):
    q, k, v, g = blk
    b = jnp.cumsum(g, axis=2)
    o_inter = jnp.einsum('bhcd,bhde->bhce', q * jnp.exp(b), state)
    C = q.shape[2]
    lower = jnp.tril(jnp.ones((C, C), dtype=bool))[:, :, None]
    diff = b[:, :, :, None, :] - b[:, :, None, :, :]
    decay = jnp.exp(jnp.where(lower, diff, -jnp.inf))
    scores = jnp.sum(q[:, :, :, None, :] * k[:, :, None, :, :] * decay, axis=-1)
    o_intra = jnp.einsum('bhij,bhje->bhie', scores, v)
    b_last = b[:, :, -1, :]
    k_dec = k * jnp.exp(b_last[:, :, None, :] - b)
    new_state = jnp.exp(b_last)[..., None] * state + jnp.einsum('bhcd,bhce->bhde', k_dec, v)
    return new_state, o_inter + o_intra


def gla_scan(q, k, v, g, s0):
    B, T, H, _ = q.shape
    nc = T // GLA_CHUNK

    def to_chunks(a):
        return a.astype(jnp.float32).reshape(B, nc, GLA_CHUNK, H, a.shape[-1]).transpose(1, 0, 3, 2, 4)

    s_final, o = lax.scan(_gla_chunk_step, s0.astype(jnp.float32),
                          (to_chunks(q), to_chunks(k), to_chunks(v), to_chunks(g)))
    o = o.transpose(1, 0, 3, 2, 4).reshape(B, T, H, v.shape[-1])
    return o, s_final


def gla_bidirectional(q, k, v, g_fwd, g_bwd, s_f0, s_b0):
    o_f, s_f = gla_scan(q, k, v, g_fwd, s_f0)
    rev = lambda a: jnp.flip(a, axis=1)
    o_b, s_b = gla_scan(rev(q), rev(k), rev(v), rev(g_bwd), s_b0)
    return o_f + rev(o_b), s_f, s_b


def trunk_layer(x, mod, rope, ctx, norm1, w_in, q_norm, k_norm, w_gate_fwd, b_gate_fwd,
                w_gate_bwd, b_gate_bwd, gla_norm, w_out, norm2, w_up, w_down):
    B, T, _ = x.shape
    shift1, scale1, gate1, shift2, scale2, gate2 = jnp.split(mod, N_MOD, axis=-1)
    h = rmsnorm(x, norm1) * (1.0 + scale1) + shift1
    proj = h @ w_in
    sizes = [ATTN_WIDTH, KV_WIDTH, KV_WIDTH, GLA_KEY_WIDTH, GLA_KEY_WIDTH,
             GLA_VAL_WIDTH, GLA_VAL_WIDTH, GLA_RANK, GLA_RANK]
    offsets = [int(s) for s in np.cumsum(sizes)[:-1]]
    q_a, k_a, v_a, q_g, k_g, v_g, o_gate, r_f, r_b = jnp.split(proj, offsets, axis=-1)

    q_a = rmsnorm(q_a.reshape(B, T, ATTN_HEADS, HEAD_DIM), q_norm)
    k_a = rmsnorm(k_a.reshape(B, T, ATTN_KV_HEADS, HEAD_DIM), k_norm)
    v_a = v_a.reshape(B, T, ATTN_KV_HEADS, HEAD_DIM)

    g_f = jax.nn.log_sigmoid((r_f @ w_gate_fwd + b_gate_fwd).astype(jnp.float32)) / GLA_TAU
    g_b = jax.nn.log_sigmoid((r_b @ w_gate_bwd + b_gate_bwd).astype(jnp.float32)) / GLA_TAU
    q_g = q_g.reshape(B, T, GLA_HEADS, GLA_DK) * (GLA_DK ** -0.5)
    k_g = k_g.reshape(B, T, GLA_HEADS, GLA_DK)
    v_g = v_g.reshape(B, T, GLA_HEADS, GLA_DV)
    g_f = g_f.reshape(B, T, GLA_HEADS, GLA_DK)
    g_b = g_b.reshape(B, T, GLA_HEADS, GLA_DK)

    if ctx is None:
        keys, vals = k_a, v_a
        s_f0 = jnp.zeros((B, GLA_HEADS, GLA_DK, GLA_DV), jnp.float32)
        s_b0 = jnp.zeros((B, GLA_HEADS, GLA_DK, GLA_DV), jnp.float32)
    else:
        k_ctx, v_ctx, s_f0, s_b0 = ctx
        q_a = apply_axial_rope(q_a, rope)
        k_lat = apply_axial_rope(k_a, rope)
        keys = jnp.concatenate([k_ctx.astype(k_lat.dtype), k_lat], axis=1)
        vals = jnp.concatenate([v_ctx.astype(v_a.dtype), v_a], axis=1)

    attn_out = block_attention(q_a, keys, vals)
    o_gla, s_f, s_b = gla_bidirectional(q_g, k_g, v_g, g_f, g_b, s_f0, s_b0)
    o_gla = (rmsnorm(o_gla, gla_norm).reshape(B, T, GLA_VAL_WIDTH) * jax.nn.silu(o_gate)).astype(x.dtype)

    mix = jnp.concatenate([attn_out, o_gla], axis=-1) @ w_out
    x = x + gate1 * mix
    h2 = rmsnorm(x, norm2) * (1.0 + scale2) + shift2
    x = x + gate2 * (jnp.square(jax.nn.relu(h2 @ w_up)) @ w_down)
    return x, (k_a, v_a, s_f, s_b)


def setup_inputs(seed: int = 0) -> dict:
    key = jax.random.key(seed)
    ks = jax.random.split(key, 24)
    f32 = jnp.float32
    n = lambda i, shape, s: jax.random.normal(ks[i], shape, f32) * s
    return {
        'x_prompt': n(0, (BATCH, SEQ, D_MODEL), 1.0),
        'x_sample': n(1, (DEC_BATCH, DEC_SEQ, D_MODEL), 1.0),
        'cache_k': n(2, (DEC_BATCH, DEPTH, PAST_LEN, ATTN_KV_HEADS, HEAD_DIM), 1.0),
        'cache_v': n(3, (DEC_BATCH, DEPTH, PAST_LEN, ATTN_KV_HEADS, HEAD_DIM), 1.0),
        'state_gla_fwd': n(4, (DEC_BATCH, DEPTH, GLA_HEADS, GLA_DK, GLA_DV), 0.5),
        'state_gla_bwd': n(5, (DEC_BATCH, DEPTH, GLA_HEADS, GLA_DK, GLA_DV), 0.5),
        'c': n(6, (DEC_BATCH, D_MODEL), 1.0),
        'c_ctx': n(7, (D_MODEL,), 1.0),
        'w_mod': n(8, (DEPTH, D_MODEL, N_MOD * D_MODEL), D_MODEL ** -0.5),
        'b_mod': n(9, (DEPTH, N_MOD * D_MODEL), 0.02),
        'norm1': 1.0 + n(10, (DEPTH, D_MODEL), 0.02),
        'w_in': n(11, (DEPTH, D_MODEL, PROJ_WIDTH), D_MODEL ** -0.5),
        'q_norm': 1.0 + n(12, (DEPTH, HEAD_DIM), 0.02),
        'k_norm': 1.0 + n(13, (DEPTH, HEAD_DIM), 0.02),
        'w_gate_fwd': n(14, (DEPTH, GLA_RANK, GLA_KEY_WIDTH), GLA_RANK ** -0.5),
        'b_gate_fwd': n(15, (DEPTH, GLA_KEY_WIDTH), 0.1),
        'w_gate_bwd': n(16, (DEPTH, GLA_RANK, GLA_KEY_WIDTH), GLA_RANK ** -0.5),
        'b_gate_bwd': n(17, (DEPTH, GLA_KEY_WIDTH), 0.1),
        'gla_norm': 1.0 + n(18, (DEPTH, GLA_DV), 0.02),
        'w_out': n(19, (DEPTH, D_MODEL, D_MODEL), D_MODEL ** -0.5),
        'norm2': 1.0 + n(20, (DEPTH, D_MODEL), 0.02),
        'w_up': n(21, (DEPTH, D_MODEL, D_FF), D_MODEL ** -0.5),
        'w_down': n(22, (DEPTH, D_FF, D_MODEL), D_FF ** -0.5),
    }


def reference(x_prompt, x_sample, cache_k, cache_v, state_gla_fwd, state_gla_bwd, c, c_ctx,
              w_mod, b_mod, norm1, w_in, q_norm, k_norm, w_gate_fwd, b_gate_fwd,
              w_gate_bwd, b_gate_bwd, gla_norm, w_out, norm2, w_up, w_down):
    rope = axial_rope_tables(x_sample.shape[1])
    silu_ctx = jax.nn.silu(c_ctx)
    silu_c = jax.nn.silu(c)
    y_p, y_s = x_prompt, x_sample
    ks, vs, sfs, sbs = [], [], [], []
    for l in range(DEPTH):
        lw = (norm1[l], w_in[l], q_norm[l], k_norm[l], w_gate_fwd[l], b_gate_fwd[l],
              w_gate_bwd[l], b_gate_bwd[l], gla_norm[l], w_out[l], norm2[l], w_up[l], w_down[l])
        mod_ctx = silu_ctx @ w_mod[l] + b_mod[l]
        y_p, (k_l, v_l, sf_l, sb_l) = trunk_layer(y_p, mod_ctx, None, None, *lw)
        ks.append(k_l)
        vs.append(v_l)
        sfs.append(sf_l)
        sbs.append(sb_l)
        mod_lat = (silu_c @ w_mod[l] + b_mod[l])[:, None, :]
        ctx = (cache_k[:, l], cache_v[:, l], state_gla_fwd[:, l], state_gla_bwd[:, l])
        y_s, _ = trunk_layer(y_s, mod_lat, rope, ctx, *lw)
    new_cache_k = jnp.stack(ks, axis=1)
    new_cache_v = jnp.stack(vs, axis=1)
    new_state_gla_fwd = jnp.stack(sfs, axis=1)
    new_state_gla_bwd = jnp.stack(sbs, axis=1)
    return (y_p, y_s, new_cache_k, new_cache_v, new_state_gla_fwd, new_state_gla_bwd)
```

```cpp
#include <hip/hip_runtime.h>
#include <cstdio>
#include <cstdint>

#ifndef MK_PER_PHASE
#define MK_PER_PHASE 0
#endif
#ifndef CONV_TAILS
#define CONV_TAILS 0
#endif
#ifndef WG_IN
#define WG_IN 4
#endif
#ifndef WG_UP
#define WG_UP 8
#endif
#ifndef WG_SPL
#define WG_SPL 4
#endif
#ifndef PRO_NT
#define PRO_NT 1
#endif
#ifndef MK_MASK
#define MK_MASK 0x3ff
#endif
#define HAS(k) ((MK_MASK >> (k)) & 1)
#ifndef MK_DUP
#define MK_DUP 0
#endif
#define DUP(k) (((MK_DUP >> (k)) & 1) ? 2 : 1)
#ifndef MK_PROBE_GLALAT
#define MK_PROBE_GLALAT 0
#endif
#ifndef MK_DUPSYNC
#define MK_DUPSYNC 0
#endif

#define LAS __attribute__((address_space(3)))
#define GAS __attribute__((address_space(1)))
typedef unsigned short bf16_t;
typedef short bf16x8 __attribute__((ext_vector_type(8)));
typedef short s16x4 __attribute__((ext_vector_type(4)));
typedef float f32x2 __attribute__((ext_vector_type(2)));
typedef float f32x4 __attribute__((ext_vector_type(4)));
typedef float f32x16 __attribute__((ext_vector_type(16)));
typedef unsigned u32x2 __attribute__((ext_vector_type(2)));
typedef unsigned u32x4 __attribute__((ext_vector_type(4)));
typedef GAS unsigned gu32;

constexpr int DM = 2048, NB_CTX = 32, S_CTX = 256, DEPTH = 4, NB_LAT = 4, S_LAT = 1024, PAST = 256;
constexpr int M_CTX = NB_CTX * S_CTX, M_LAT = NB_LAT * S_LAT, M = M_CTX + M_LAT;
constexpr int HD = 128, NQH = 8, NKVH = 2, KVW = 256, GH = 8, GDK = 64, GDV = 128, GRANK = 16;
constexpr int DFF = 8192, PROJ_W = 4640, PROJ_P = 4864;
constexpr int C_Q = 0, C_K = 1024, C_V = 1280, C_QG = 1536, C_KG = 2048, C_VG = 2560, C_OG = 3584, C_RF = 4608, C_RB = 4624;
constexpr int NGRP = 1 + NB_LAT;
constexpr int S_KVL = PAST + S_LAT;
constexpr float EPS = 1e-6f;

constexpr size_t MiB = 1u << 20;
constexpr size_t WS_CTL = 0, CTL_ZERO_BYTES = 128 * 1024;
constexpr size_t WS_MOD = 1 * MiB;
constexpr size_t WS_ROPE = 2 * MiB;
constexpr size_t WS_WIN = 4 * MiB;
constexpr size_t WS_WOUT = 80 * MiB;
constexpr size_t WS_WUP = 112 * MiB;
constexpr size_t WS_WDN = 240 * MiB;
constexpr size_t WS_H = 368 * MiB;
constexpr size_t WS_PROJ = 416 * MiB;
constexpr size_t WS_MIXA = 530 * MiB;
constexpr size_t WS_HID = 578 * MiB;
constexpr size_t WS_KC = 770 * MiB, WS_VC = 774 * MiB;
constexpr size_t WS_KL = 778 * MiB, WS_VL = 788 * MiB;
constexpr size_t WS_OF = 798 * MiB, WS_OB = 846 * MiB;
constexpr size_t WS_SIDE = 894 * MiB;
constexpr size_t WS_XB = 912 * MiB;
constexpr size_t WS_END = 960 * MiB;
static_assert(WS_WIN + (size_t)DEPTH * PROJ_P * DM * 2 <= WS_WOUT && WS_PROJ + (size_t)M * PROJ_P * 2 <= WS_MIXA && WS_HID + (size_t)M * DFF * 2 <= WS_KC, "ws map");
static_assert(WS_KL + (size_t)DEPTH * NB_LAT * S_KVL * KVW * 2 <= WS_VL && WS_OF + (size_t)M * 1024 * 4 <= WS_OB, "ws map 2");
constexpr int CW_BAR = 4096;
constexpr int CW_Q = 16384;
constexpr size_t OUT_Y = 0, OUT_CK = (size_t)M * DM, OUT_CV = OUT_CK + (size_t)M_CTX * DEPTH * KVW, OUT_SF = OUT_CV + (size_t)M_CTX * DEPTH * KVW,
                 OUT_SB = OUT_SF + (size_t)NB_CTX * DEPTH * GH * GDK * GDV, OUT_END = OUT_SB + (size_t)NB_CTX * DEPTH * GH * GDK * GDV;

constexpr int RING_BYTES = 131072, MISC_OFF = RING_BYTES + 320, LDS_BYTES = 147456;

typedef __bf16 bf16x2_t __attribute__((ext_vector_type(2)));
typedef short s16x4 __attribute__((ext_vector_type(4)));
__device__ __forceinline__ unsigned cvt_pk_bf16(float lo, float hi) { const f32x2 v = {lo, hi}; const bf16x2_t b = __builtin_convertvector(v, bf16x2_t); return __builtin_bit_cast(unsigned, b); }
__device__ __forceinline__ unsigned f2bf(float f) { unsigned u = __builtin_bit_cast(unsigned, f); return (u + 0x7fffu + ((u >> 16) & 1u)) >> 16; }
__device__ __forceinline__ unsigned pk2(float lo, float hi) { return f2bf(lo) | (f2bf(hi) << 16); }
__device__ __forceinline__ float bf2f(unsigned short b) { return __builtin_bit_cast(float, ((unsigned)b) << 16); }
__device__ __forceinline__ float bflo(unsigned w) { return __builtin_bit_cast(float, w << 16); }
__device__ __forceinline__ float bfhi(unsigned w) { return __builtin_bit_cast(float, w & 0xffff0000u); }
__device__ __forceinline__ int tid_fresh() { int t = threadIdx.x; asm volatile("" : "+v"(t)); return t; }
#define LDS_WAIT() asm volatile("s_waitcnt lgkmcnt(0)" ::: "memory")
#define VM_WAIT() asm volatile("s_waitcnt vmcnt(0)" ::: "memory")

__device__ __forceinline__ float* mk_out_ptr();
namespace pg8 {
constexpr int BM = 256, BK = 64, HALF = 128, HTB = HALF * BK * 2, STAGE_BYTES = 8 * HTB, NXCD = 8;
__host__ __device__ __forceinline__ int lds_byte(int r, int c) { const int st = (r >> 4) * 2 + (c >> 5), rr = r & 15, cc = c & 31, ob = rr * 64 + cc * 2; return st * 1024 + (ob ^ (((ob >> 9) & 1) << 5)); }
__host__ __device__ __forceinline__ void stage_rc(int b, int& R, int& C) { const int st = b / 1024, sb = b % 1024, swz = sb ^ (((sb >> 9) & 1) << 5); R = (st >> 1) * 16 + swz / 64; C = (st & 1) * 32 + (swz % 64) / 2; }
__host__ __device__ __forceinline__ int perm32(int rho) { const int n = rho >> 4, i = rho & 15; return 8 * (i >> 2) + 4 * n + (i & 3); }

struct Unit { int pm, pn, k0, nt, aux; };
struct Gemm { const bf16_t* A; const bf16_t* Bt; int M, N, K; };

struct StaticOrder {
    int nM, nN, nwg, G, c, ntf, WGM;
    __device__ void init(int M_, int N_, int G_, int c_, int K_, int wgm = 4) { nM = M_ / BM; nN = N_ / BM; nwg = nM * nN; G = G_; c = c_; ntf = K_ / BK; WGM = wgm; }
    __device__ void map(int wgid, Unit& u) const {
        { const int q = nwg / NXCD, r = nwg % NXCD, xcd = wgid % NXCD, off = wgid / NXCD; wgid = (xcd < r ? xcd * (q + 1) : r * (q + 1) + (xcd - r) * q) + off; }
        const int nig = WGM * nN, gid = wgid / nig, fm = gid * WGM, gsz = (nM - fm) < WGM ? (nM - fm) : WGM;
        u.pm = fm + ((wgid % nig) % gsz); u.pn = (wgid % nig) / gsz; u.k0 = 0; u.nt = ntf; u.aux = 0;
    }
    __device__ bool next(int i, Unit& u) const { const long L = (long)i * G + c; if (L >= nwg) return false; map((int)L, u); return true; }
    __device__ __forceinline__ void a_ready(const Unit&) const {}
    __device__ __forceinline__ void done(const Unit&) const {}
};
struct InOrder {
    int G, c, base, limit;
    __device__ void init(int G_, int c_, int base_, int limit_) { G = G_; c = c_; base = base_; limit = limit_; }
    __device__ bool next(int i, Unit& u) const {
        const long L = (long)base + (long)i * G + c; if (L >= limit) return false;
        const int xcd = (int)(L % NXCD), off = (int)(L / NXCD);
        if (off >= 58 && off < 96) { const int j = 38 * xcd + (off - 58), gid = j / 76, w = j % 76; u.pm = M_CTX / BM + 4 * gid + (w & 3); u.pn = w >> 2; }
        else { const int w = off < 58 ? off : off - 38; u.pm = 4 * xcd + (w & 3); u.pn = w >> 2; }
        u.k0 = 0; u.nt = DM / BK; u.aux = 0; return true;
    }
    __device__ __forceinline__ void a_ready(const Unit&) const {}
    __device__ __forceinline__ void done(const Unit&) const {}
};
static_assert((M_LAT / BM) * (PROJ_P / BM) == 8 * 38 && (M_CTX / BM) * (PROJ_P / BM) == 8 * 76, "InOrder: 38 latent + 76 context units per XCD slot");
struct SplitLatOrder {
    StaticOrder sa, sb; int G, c, nth;
    __device__ void init(int K_, int G_, int c_, int wgm = 4) { G = G_; c = c_; nth = K_ / BK / 2; sa.init(M_CTX, DM, G_, c_, K_, wgm); sb.init(M_LAT, 2 * DM, G_, c_, K_, wgm); }
    __device__ bool next(int i, Unit& u) const {
        long L = (long)i * G + c;
        if (G == sa.nwg && G == sb.nwg && (c & 4) && i < 2) L = (long)(1 - i) * G + c;
        if (L < sa.nwg) { sa.map((int)L, u); return true; }
        if (L < sa.nwg + sb.nwg) { sb.map((int)(L - sa.nwg), u); const int kh = u.pn >> 3; u.pn &= 7; u.pm += M_CTX / BM; u.k0 = kh * nth * BK; u.nt = nth; u.aux = kh; return true; }
        return false;
    }
    __device__ __forceinline__ void a_ready(const Unit&) const {}
    __device__ __forceinline__ void done(const Unit&) const {}
};

template <int ACT  > struct EpiBf16 {
    static constexpr bool PERM = true, AFTER_DRAIN = false;
    bf16_t* O; int ldc;
    __device__ __forceinline__ void operator()(const f32x4 (&acc)[2][2][4][2], const Unit& u, int wr, int wc, int fr, int fq) const {
        const int row0 = u.pm * BM + wr * 64 + fr, col0 = u.pn * BM + wc * 32 + 8 * fq;
#pragma unroll
        for (int ai = 0; ai < 2; ++ai)
#pragma unroll
            for (int m = 0; m < 4; ++m) { bf16_t* rowp = O + (size_t)(row0 + ai * HALF + m * 16) * ldc + col0;
#pragma unroll
                for (int bj = 0; bj < 2; ++bj) { f32x4 v0 = acc[ai][bj][m][0], v1 = acc[ai][bj][m][1];
                    if (ACT == 1) {
#pragma unroll
                        for (int j = 0; j < 4; ++j) { const float a = fmaxf(v0[j], 0.f), b = fmaxf(v1[j], 0.f); v0[j] = a * a; v1[j] = b * b; } }
                    u32x4 w; w.x = cvt_pk_bf16(v0[0], v0[1]); w.y = cvt_pk_bf16(v0[2], v0[3]); w.z = cvt_pk_bf16(v1[0], v1[1]); w.w = cvt_pk_bf16(v1[2], v1[3]);
                    *(u32x4*)(rowp + bj * HALF) = w; } }
    }
};
struct EpiIn {
    static constexpr bool PERM = true, AFTER_DRAIN = false;
    bf16_t* O; unsigned char* ws; float* out; const float* kn; LAS float* xl; int l;
    __device__ __forceinline__ void operator()(const f32x4 (&acc)[2][2][4][2], const Unit& u, int wr, int wc, int fr, int fq_) const {
        int fq = fq_;
        int rl0 = wr * 64 + fr;
        asm volatile("" : "+v"(rl0), "+v"(fq));
        const bool lat = u.pm >= M_CTX / BM;
        const int b = lat ? (u.pm - M_CTX / BM) >> 2 : u.pm, t0 = lat ? ((u.pm - M_CTX / BM) & 3) * 256 : 0;
        bf16_t* kvdst = (bf16_t*)(ws + (u.pn == 4 ? (lat ? WS_KL : WS_KC) : (lat ? WS_VL : WS_VC))) + (lat ? ((size_t)(l * NB_LAT + b) * S_KVL + PAST + t0) * KVW : (size_t)u.pm * BM * KVW);
        float* cout = out + (u.pn == 4 ? OUT_CK : OUT_CV) + ((size_t)b * DEPTH + l) * S_CTX * KVW;
        if (u.pn != 4) {
            const bool isv = u.pn == 5;
            bf16_t* dst = isv ? kvdst + wc * 32 + 8 * fq : O + (size_t)u.pm * BM * PROJ_P + u.pn * BM + wc * 32 + 8 * fq;
            const int ld = isv ? KVW : PROJ_P;
            float* co = cout + wc * 32 + 8 * fq;
#pragma unroll
            for (int ai = 0; ai < 2; ++ai)
#pragma unroll
                for (int m = 0; m < 4; ++m) { const int rl = rl0 + ai * HALF + m * 16;
#pragma unroll
                    for (int bj = 0; bj < 2; ++bj) { const f32x4 v0 = acc[ai][bj][m][0], v1 = acc[ai][bj][m][1];
                        u32x4 w; w.x = cvt_pk_bf16(v0[0], v0[1]); w.y = cvt_pk_bf16(v0[2], v0[3]); w.z = cvt_pk_bf16(v1[0], v1[1]); w.w = cvt_pk_bf16(v1[2], v1[3]);
                        *(u32x4*)(dst + rl * ld + bj * HALF) = w;
                        if (isv && !lat) { *(f32x4*)(co + rl * KVW + bj * HALF) = v0; *(f32x4*)(co + rl * KVW + bj * HALF + 4) = v1; } }
                    asm volatile("" ::: "memory"); }
            return;
        }
        const int g = 4 * wc + fq, base = g < 8 ? 4 * g : 64 + 4 * (g - 8);
        const float* RP = (const float*)(ws + WS_ROPE);
        const int rpo = (g >> 3) * 64 + 4 * (g & 7);
        f32x4 rcv[2][4], rsv[2][4];
#pragma unroll
        for (int ai = 0; ai < 2; ++ai)
#pragma unroll
            for (int m = 0; m < 4; ++m) { rcv[ai][m] = (f32x4){1.f, 1.f, 1.f, 1.f}; rsv[ai][m] = (f32x4){0.f, 0.f, 0.f, 0.f};
                if (lat) { const float* rp = RP + (size_t)(t0 + rl0 + ai * HALF + m * 16) * 128 + rpo; rcv[ai][m] = *(const f32x4*)rp; rsv[ai][m] = *(const f32x4*)(rp + 32); } }
        const f32x4 gk0 = *(const f32x4*)(kn + base), gk1 = *(const f32x4*)(kn + base + 32);
#pragma unroll
        for (int ai = 0; ai < 2; ++ai)
#pragma unroll
            for (int m = 0; m < 4; ++m)
#pragma unroll
                for (int bj = 0; bj < 2; ++bj) { const f32x4 v0 = acc[ai][bj][m][0], v1 = acc[ai][bj][m][1];
                    float ss = (v0[0] * v0[0] + v0[1] * v0[1]) + (v0[2] * v0[2] + v0[3] * v0[3]) + (v1[0] * v1[0] + v1[1] * v1[1]) + (v1[2] * v1[2] + v1[3] * v1[3]);
                    ss += __shfl_xor(ss, 16); ss += __shfl_xor(ss, 32);
                    if (fq == 0) xl[((rl0 + ai * HALF + m * 16) * 2 + bj) * 4 + wc] = ss; }
        asm volatile("s_waitcnt lgkmcnt(0)" ::: "memory"); __builtin_amdgcn_s_barrier(); asm volatile("" ::: "memory");
#pragma unroll
        for (int ai = 0; ai < 2; ++ai)
#pragma unroll
            for (int m = 0; m < 4; ++m) { const int rl = rl0 + ai * HALF + m * 16; const f32x4 rc = rcv[ai][m], rs = rsv[ai][m];
#pragma unroll
                for (int bj = 0; bj < 2; ++bj) { const f32x4 pp = *(const LAS f32x4*)(xl + (rl * 2 + bj) * 4);
                    const float rstd = __builtin_amdgcn_rsqf(((pp[0] + pp[1]) + (pp[2] + pp[3])) * (1.0f / HD) + EPS);
                    const f32x4 y0 = acc[ai][bj][m][0] * rstd * gk0, y1 = acc[ai][bj][m][1] * rstd * gk1;
                    if (!lat) { *(f32x4*)(cout + (size_t)rl * KVW + bj * HALF + base) = y0; *(f32x4*)(cout + (size_t)rl * KVW + bj * HALF + base + 32) = y1; }
                    const f32x4 z0 = y0 * rc - y1 * rs, z1 = y1 * rc + y0 * rs;
                    u32x2 w0, w1; w0.x = cvt_pk_bf16(z0[0], z0[1]); w0.y = cvt_pk_bf16(z0[2], z0[3]); w1.x = cvt_pk_bf16(z1[0], z1[1]); w1.y = cvt_pk_bf16(z1[2], z1[3]);
                    *(u32x2*)(kvdst + (size_t)rl * KVW + bj * HALF + base) = w0; *(u32x2*)(kvdst + (size_t)rl * KVW + bj * HALF + base + 32) = w1; } }
    }
};
struct EpiResid {
    static constexpr bool PERM = true, AFTER_DRAIN = false;
    bf16_t* xb; const float* gate; bf16_t* side; int dry;
    __device__ __forceinline__ void operator()(const f32x4 (&acc)[2][2][4][2], const Unit& u, int wr, int wc, int fr, int fq) const {
        if (dry == 1) return;
        const int row0 = u.pm * BM + wr * 64 + fr, col0 = u.pn * BM + wc * 32 + 8 * fq;
        const int grp = u.pm < (M_CTX / BM) ? 0 : 1 + ((u.pm - M_CTX / BM) >> 2);
        const float* gp = gate + (size_t)grp * (6 * DM) + col0;
        f32x4 gv[2][2];
#pragma unroll
        for (int bj = 0; bj < 2; ++bj)
#pragma unroll
            for (int n = 0; n < 2; ++n) gv[bj][n] = *(const f32x4*)(gp + bj * HALF + 4 * n);
        if (u.aux) {
            bf16_t* sp = side + (size_t)(row0 - M_CTX) * DM + col0;
#pragma unroll
            for (int ai = 0; ai < 2; ++ai)
#pragma unroll
                for (int m = 0; m < 4; ++m)
#pragma unroll
                    for (int bj = 0; bj < 2; ++bj) { const f32x4 v0 = gv[bj][0] * acc[ai][bj][m][0], v1 = gv[bj][1] * acc[ai][bj][m][1];
                        u32x4 w; w.x = cvt_pk_bf16(v0[0], v0[1]); w.y = cvt_pk_bf16(v0[2], v0[3]); w.z = cvt_pk_bf16(v1[0], v1[1]); w.w = cvt_pk_bf16(v1[2], v1[3]);
                        *(u32x4*)(sp + (size_t)(ai * HALF + m * 16) * DM + bj * HALF) = w; }
            return;
        }
        bf16_t* xp = xb + (size_t)row0 * DM + col0;
        u32x4 bq[2][4][2];
#pragma unroll
        for (int ai = 0; ai < 2; ++ai)
#pragma unroll
            for (int m = 0; m < 4; ++m)
#pragma unroll
                for (int bj = 0; bj < 2; ++bj) bq[ai][m][bj] = *(const u32x4*)(xp + (size_t)(ai * HALF + m * 16) * DM + bj * HALF);
#pragma unroll
        for (int ai = 0; ai < 2; ++ai)
#pragma unroll
            for (int m = 0; m < 4; ++m)
#pragma unroll
                for (int bj = 0; bj < 2; ++bj) { const u32x4 b = bq[ai][m][bj]; const f32x4 a0 = gv[bj][0] * acc[ai][bj][m][0], a1 = gv[bj][1] * acc[ai][bj][m][1];
                    if (dry == 2 && u.pm < M_CTX / BM) { float* yp = mk_out_ptr() + OUT_Y + (size_t)(row0 + ai * HALF + m * 16) * DM + col0 + bj * HALF;
                        __builtin_nontemporal_store((f32x4){bflo(b.x) + a0[0], bfhi(b.x) + a0[1], bflo(b.y) + a0[2], bfhi(b.y) + a0[3]}, (f32x4*)yp);
                        __builtin_nontemporal_store((f32x4){bflo(b.z) + a1[0], bfhi(b.z) + a1[1], bflo(b.w) + a1[2], bfhi(b.w) + a1[3]}, (f32x4*)(yp + 4)); continue; }
                    u32x4 w; w.x = cvt_pk_bf16(bflo(b.x) + a0[0], bfhi(b.x) + a0[1]); w.y = cvt_pk_bf16(bflo(b.y) + a0[2], bfhi(b.y) + a0[3]);
                    w.z = cvt_pk_bf16(bflo(b.z) + a1[0], bfhi(b.z) + a1[1]); w.w = cvt_pk_bf16(bflo(b.w) + a1[2], bfhi(b.w) + a1[3]);
                    *(u32x4*)(xp + (size_t)(ai * HALF + m * 16) * DM + bj * HALF) = w; }
    }
};

template <class Epi, class Sched, bool ALIGN_EPI = false, bool SP2 = false>
__device__ __forceinline__ void gemm_phase(LAS unsigned char* lds, const Gemm g, const Sched& S, const Epi& E) {
    const int tid = tid_fresh(), wid = __builtin_amdgcn_readfirstlane(tid >> 6), lane = tid & 63, wr = wid >> 2, wc = wid & 3, fr = lane & 15, fq = lane >> 4;
    const int K = g.K;
    unsigned voffA[2], voffB[2];
#pragma unroll
    for (int i = 0; i < 2; ++i) { int R, C; stage_rc(tid * 16 + i * 8192, R, C); const int Rb = Epi::PERM ? ((R & ~31) + perm32(R & 31)) : R;
        voffA[i] = (unsigned)(R * K + C) * 2u; voffB[i] = (unsigned)(Rb * K + C) * 2u; }
    const size_t kstep = (size_t)(BK * 2);
    const size_t hstep = (size_t)HALF * K * 2;
    const size_t tstep = 2 * hstep;
    const unsigned ldsw = (unsigned)wid * 1024u;
    const int aoff = lds_byte(wr * 64 + fr, fq * 8), boff = lds_byte(wc * 32 + fr, fq * 8);
#define PG8_SA(b, h) (((b) * 2 + (h)) * HTB)
#define PG8_SB(b, h) ((4 + (b) * 2 + (h)) * HTB)
#define PG8_STAGE(bufoff, gbase, voff) do { _Pragma("unroll") for (int _i = 0; _i < 2; ++_i) \
        __builtin_amdgcn_global_load_lds((const unsigned*)((const char*)(gbase) + (voff)[_i]), (LAS unsigned*)(lds + (bufoff) + ldsw + _i * 8192), 16, 0, 0); } while (0)
#define PG8_LDA(dst, b, h) do { _Pragma("unroll") for (int m = 0; m < 4; ++m) _Pragma("unroll") for (int k = 0; k < 2; ++k) dst[m][k] = *(const LAS bf16x8*)(lds + PG8_SA(b, h) + aoff + m * 2048 + k * 1024); } while (0)
#define PG8_LDB(dst, b, h) do { _Pragma("unroll") for (int n = 0; n < 2; ++n) _Pragma("unroll") for (int k = 0; k < 2; ++k) dst[n][k] = *(const LAS bf16x8*)(lds + PG8_SB(b, h) + boff + n * 2048 + k * 1024); } while (0)
#define PG8_MMA(ai, bj, At, Bt) do { __builtin_amdgcn_s_setprio(1); _Pragma("unroll") for (int m = 0; m < 4; ++m) _Pragma("unroll") for (int n = 0; n < 2; ++n) _Pragma("unroll") for (int k = 0; k < 2; ++k) \
        acc[ai][bj][m][n] = __builtin_amdgcn_mfma_f32_16x16x32_bf16(Bt[n][k], At[m][k], acc[ai][bj][m][n], 0, 0, 0); __builtin_amdgcn_s_setprio(0); } while (0)
#define PG8_WAIT_V(n) asm volatile("s_waitcnt vmcnt(" #n ")" ::: "memory")
#define PG8_WAIT_L(n) asm volatile("s_waitcnt lgkmcnt(" #n ")" ::: "memory")
#define PG8_BAR __builtin_amdgcn_s_barrier()
#define PG8_SCHED __builtin_amdgcn_sched_barrier(0)
    Unit cur, nxt; int ui = 0;
    if (!S.next(0, cur)) return;
    f32x4 acc[2][2][4][2];
#pragma unroll
    for (int a = 0; a < 2; ++a)
#pragma unroll
        for (int b = 0; b < 2; ++b)
#pragma unroll
            for (int m = 0; m < 4; ++m)
#pragma unroll
                for (int n = 0; n < 2; ++n) acc[a][b][m][n] = (f32x4){0.f, 0.f, 0.f, 0.f};
    bf16x8 At[4][2], B0[2][2], B1[2][2];
    const char* cA = (const char*)g.A + (size_t)cur.pm * tstep + (size_t)cur.k0 * 2; const char* cB = (const char*)g.Bt + (size_t)cur.pn * tstep + (size_t)cur.k0 * 2;
    S.a_ready(cur);
    if constexpr (SP2) {
        PG8_STAGE(PG8_SB(0, 0), cB, voffB); PG8_STAGE(PG8_SB(0, 1), cB + hstep, voffB); PG8_STAGE(PG8_SA(0, 0), cA, voffA); PG8_STAGE(PG8_SA(0, 1), cA + hstep, voffA);
        if (wr == 1) PG8_BAR;
        PG8_WAIT_V(2); PG8_BAR;
        PG8_STAGE(PG8_SB(1, 0), cB + kstep, voffB); PG8_STAGE(PG8_SA(1, 0), cA + kstep, voffA); PG8_STAGE(PG8_SB(1, 1), cB + hstep + kstep, voffB);
        PG8_WAIT_V(6); PG8_BAR;
    } else {
        PG8_STAGE(PG8_SB(0, 0), cB, voffB); PG8_STAGE(PG8_SA(0, 0), cA, voffA); PG8_STAGE(PG8_SB(0, 1), cB + hstep, voffB); PG8_STAGE(PG8_SA(0, 1), cA + hstep, voffA);
        if (wr == 1) PG8_BAR;
        PG8_WAIT_V(4); PG8_BAR;
        PG8_STAGE(PG8_SB(1, 0), cB + kstep, voffB); PG8_STAGE(PG8_SA(1, 0), cA + kstep, voffA); PG8_STAGE(PG8_SB(1, 1), cB + hstep + kstep, voffB);
        PG8_WAIT_V(6); PG8_BAR;
    }
    for (;;) {
        const bool has_next = S.next(ui + 1, nxt);
        const char* nA = has_next ? (const char*)g.A + (size_t)nxt.pm * tstep + (size_t)nxt.k0 * 2 : cA; const char* nB = has_next ? (const char*)g.Bt + (size_t)nxt.pn * tstep + (size_t)nxt.k0 * 2 : cB;
        const int nt = cur.nt;
        for (int t = 0; t < nt; t += 2) {
            const bool last = (t == nt - 2);
            const char* a1 = cA + (size_t)(t + 1) * kstep;
            const char* a2 = last ? nA : cA + (size_t)(t + 2) * kstep; const char* b2 = last ? nB : cB + (size_t)(t + 2) * kstep;
            const char* a3 = a2 + kstep; const char* b3 = b2 + kstep;
            if (last && has_next) S.a_ready(nxt);
            if constexpr (SP2) {
            PG8_LDB(B0, 0, 0); PG8_LDB(B1, 0, 1); PG8_SCHED; PG8_LDA(At, 0, 0); PG8_STAGE(PG8_SA(1, 1), a1 + hstep, voffA);
            PG8_WAIT_V(8); PG8_WAIT_L(0); PG8_BAR; PG8_MMA(0, 0, At, B0); PG8_MMA(0, 1, At, B1); PG8_BAR; PG8_SCHED;
            PG8_LDA(At, 0, 1); PG8_STAGE(PG8_SB(0, 0), b2, voffB); PG8_STAGE(PG8_SB(0, 1), b2 + hstep, voffB); PG8_STAGE(PG8_SA(0, 0), a2, voffA);
            PG8_WAIT_V(8); PG8_WAIT_L(0); PG8_BAR; PG8_MMA(1, 0, At, B0); PG8_MMA(1, 1, At, B1); PG8_BAR; PG8_SCHED;
            PG8_LDB(B0, 1, 0); PG8_LDB(B1, 1, 1); PG8_SCHED; PG8_LDA(At, 1, 0); PG8_STAGE(PG8_SA(0, 1), a2 + hstep, voffA);
            PG8_WAIT_V(8); PG8_WAIT_L(0); PG8_BAR; PG8_MMA(0, 0, At, B0); PG8_MMA(0, 1, At, B1); PG8_BAR; PG8_SCHED;
            PG8_LDA(At, 1, 1); PG8_STAGE(PG8_SB(1, 0), b3, voffB); PG8_STAGE(PG8_SB(1, 1), b3 + hstep, voffB); PG8_STAGE(PG8_SA(1, 0), a3, voffA);
            PG8_WAIT_V(8); PG8_WAIT_L(0); PG8_BAR; PG8_MMA(1, 0, At, B0); PG8_MMA(1, 1, At, B1); PG8_BAR; PG8_SCHED;
            } else {
            PG8_LDB(B0, 0, 0); PG8_SCHED; PG8_LDA(At, 0, 0); PG8_STAGE(PG8_SA(1, 1), a1 + hstep, voffA);
            PG8_WAIT_L(8); PG8_BAR; PG8_WAIT_L(0); PG8_MMA(0, 0, At, B0); PG8_BAR; PG8_SCHED;
            PG8_LDB(B1, 0, 1); PG8_STAGE(PG8_SB(0, 0), b2, voffB);
            PG8_BAR; PG8_WAIT_L(0); PG8_MMA(0, 1, At, B1); PG8_BAR;
            PG8_LDA(At, 0, 1); PG8_STAGE(PG8_SA(0, 0), a2, voffA);
            PG8_BAR; PG8_WAIT_L(0); PG8_MMA(1, 0, At, B0); PG8_BAR; PG8_SCHED;
            PG8_STAGE(PG8_SB(0, 1), b2 + hstep, voffB);
            PG8_WAIT_V(6); PG8_BAR; PG8_MMA(1, 1, At, B1); PG8_BAR;
            PG8_LDB(B0, 1, 0); PG8_SCHED; PG8_LDA(At, 1, 0); PG8_STAGE(PG8_SA(0, 1), a2 + hstep, voffA);
            PG8_WAIT_L(8); PG8_BAR; PG8_WAIT_L(0); PG8_MMA(0, 0, At, B0); PG8_BAR; PG8_SCHED;
            PG8_LDB(B1, 1, 1); PG8_STAGE(PG8_SB(1, 0), b3, voffB);
            PG8_BAR; PG8_WAIT_L(0); PG8_MMA(0, 1, At, B1); PG8_BAR;
            PG8_LDA(At, 1, 1); PG8_STAGE(PG8_SA(1, 0), a3, voffA);
            PG8_BAR; PG8_WAIT_L(0); PG8_MMA(1, 0, At, B0); PG8_BAR; PG8_SCHED;
            PG8_STAGE(PG8_SB(1, 1), b3 + hstep, voffB);
            PG8_WAIT_V(6); PG8_BAR; PG8_MMA(1, 1, At, B1); PG8_BAR;
            }
        }
        if constexpr (ALIGN_EPI) { if (wr == 0) PG8_BAR; }
        if constexpr (!Epi::AFTER_DRAIN) { E(acc, cur, wr, wc, fr, fq); S.done(cur); }
        if (!has_next) break;
#pragma unroll
        for (int a = 0; a < 2; ++a)
#pragma unroll
            for (int b = 0; b < 2; ++b)
#pragma unroll
                for (int m = 0; m < 4; ++m)
#pragma unroll
                    for (int n = 0; n < 2; ++n) acc[a][b][m][n] = (f32x4){0.f, 0.f, 0.f, 0.f};
        cur = nxt; cA = nA; cB = nB; ++ui;
        if constexpr (ALIGN_EPI) { if (wr == 1) PG8_BAR; }
    }
    PG8_WAIT_V(0);
    if constexpr (!ALIGN_EPI) { if (wr == 0) PG8_BAR; }
    PG8_BAR;
#undef PG8_SA
#undef PG8_SB
#undef PG8_STAGE
#undef PG8_LDA
#undef PG8_LDB
#undef PG8_MMA
#undef PG8_WAIT_V
#undef PG8_WAIT_L
#undef PG8_BAR
#undef PG8_SCHED
}
}

namespace att {
constexpr int D = 128, NW = 8, QBLK = 32, KVBLK = 64;
constexpr float SCALE = 0.088388347648318440f;
constexpr float THR = 8.f;
constexpr size_t SHM_V = KVBLK * D * 2, SHM_K = KVBLK * D * 2, SHM_ATTN = 2 * SHM_V + 2 * SHM_K + NW * 64 * 4;
#define KSWZ(row, colB) ((row) * 256 + ((colB) ^ (((row) & 7) << 4)))
#define SBAR() __builtin_amdgcn_sched_barrier(0)
__device__ __forceinline__ int crow(int r, int hi) { return (r & 3) + 8 * (r >> 2) + 4 * hi; }
__device__ __forceinline__ unsigned cvtpk(float lo, float hi) { unsigned r; asm volatile("v_cvt_pk_bf16_f32 %0, %1, %2" : "=v"(r) : "v"(lo), "v"(hi)); return r; }

__device__ __forceinline__ void partialSM(f32x16& p0, f32x16& p1, float& m_reg, float& mn, float& alpha) {
  constexpr float C = SCALE * 1.4426950408889634f;
  float pmax = p0[0];
#pragma unroll
  for (int r = 1; r < 16; ++r) pmax = fmaxf(pmax, p0[r]);
#pragma unroll
  for (int r = 0; r < 16; ++r) pmax = fmaxf(pmax, p1[r]);
  { auto rr = __builtin_amdgcn_permlane32_swap(__float_as_uint(pmax), __float_as_uint(pmax), false, false);
    pmax = fmaxf(__uint_as_float(rr[0]), __uint_as_float(rr[1])); }
  if (__builtin_expect(__all(pmax - m_reg <= THR / SCALE), 1)) { mn = m_reg; alpha = 1.f; }
  else { mn = fmaxf(m_reg, pmax); alpha = __builtin_amdgcn_exp2f((m_reg - mn) * C); m_reg = mn; }
  float mnC = -mn * C;
#pragma unroll
  for (int r = 0; r < 16; ++r) p0[r] = fmaf(p0[r], C, mnC);
#pragma unroll
  for (int r = 0; r < 16; ++r) p1[r] = fmaf(p1[r], C, mnC);
#pragma unroll
  for (int r = 0; r < 16; ++r) p0[r] = __builtin_amdgcn_exp2f(p0[r]);
}
__device__ __forceinline__ void finishSM(f32x16& p0, f32x16& p1, float alpha, float& l_reg, bf16x8& pa0, bf16x8& pa1, bf16x8& pa2, bf16x8& pa3) {
#pragma unroll
  for (int r = 0; r < 16; ++r) p1[r] = __builtin_amdgcn_exp2f(p1[r]);
  float ps = 0;
#pragma unroll
  for (int r = 0; r < 16; ++r) ps += p0[r];
#pragma unroll
  for (int r = 0; r < 16; ++r) ps += p1[r];
  { auto rr = __builtin_amdgcn_permlane32_swap(__float_as_uint(ps), __float_as_uint(ps), false, false);
    ps = __uint_as_float(rr[0]) + __uint_as_float(rr[1]); }
  l_reg = l_reg * alpha + ps;
#define PK4(P, BASE, OUT) do { unsigned a0 = cvtpk(P[BASE + 0], P[BASE + 1]), a1 = cvtpk(P[BASE + 2], P[BASE + 3]);   \
    unsigned b0 = cvtpk(P[BASE + 4], P[BASE + 5]), b1 = cvtpk(P[BASE + 6], P[BASE + 7]);                              \
    auto r0 = __builtin_amdgcn_permlane32_swap(a0, b0, false, false); auto r1 = __builtin_amdgcn_permlane32_swap(a1, b1, false, false); \
    u32x4 w = {r0[0], r1[0], r0[1], r1[1]}; OUT = __builtin_bit_cast(bf16x8, w); } while (0)
  PK4(p0, 0, pa0); PK4(p0, 8, pa1); PK4(p1, 0, pa2); PK4(p1, 8, pa3);
#undef PK4
}
__device__ __forceinline__ void qkt(f32x16& p0, f32x16& p1, const char* Ks, const bf16x8* qr, int r32, int hi) {
  p0 = f32x16{}; p1 = f32x16{};
#pragma unroll
  for (int d0 = 0; d0 < 8; ++d0) { int cb = (d0 * 16 + hi * 8) * 2;
    bf16x8 b0 = *reinterpret_cast<const bf16x8*>(Ks + KSWZ(r32, cb));
    bf16x8 b1 = *reinterpret_cast<const bf16x8*>(Ks + KSWZ(32 + r32, cb));
    p0 = __builtin_amdgcn_mfma_f32_32x32x16_bf16(b0, qr[d0], p0, 0, 0, 0);
    p1 = __builtin_amdgcn_mfma_f32_32x32x16_bf16(b1, qr[d0], p1, 0, 0, 0); }
}
__device__ __forceinline__ int v_st(int k, int c) { const int kk = (k & ~0xC) | ((k & 4) << 1) | ((k & 8) >> 1); return ((kk >> 3) * 4 + (c >> 5)) * 512 + ((kk & 7) * 32 + (c & 31)) * 2; }
__device__ __forceinline__ int v_rd_base(int lane) { return ((lane & 3) << 3) | (((lane >> 2) & 3) << 6) | (((lane >> 4) & 1) << 5) | (((lane >> 5) & 1) << 8); }
constexpr int v_rd_off(int d0, int ks, int half) { return d0 * 512 + ks * 4096 + half * 2048; }
template <int OFF> __device__ __forceinline__ s16x4 tr_read(int vb) {
  s16x4 r; asm volatile("ds_read_b64_tr_b16 %0, %1 offset:%2" : "=&v"(r) : "v"(vb), "i"(OFF) : "memory"); return r;
}
template <int D0> __device__ __forceinline__ void pv_one(f32x16& od, int vb, bf16x8 pa0, bf16x8 pa1, bf16x8 pa2, bf16x8 pa3) {
  const s16x4 l0 = tr_read<v_rd_off(D0, 0, 0)>(vb), h0 = tr_read<v_rd_off(D0, 0, 1)>(vb), l1 = tr_read<v_rd_off(D0, 1, 0)>(vb), h1 = tr_read<v_rd_off(D0, 1, 1)>(vb);
  const s16x4 l2 = tr_read<v_rd_off(D0, 2, 0)>(vb), h2 = tr_read<v_rd_off(D0, 2, 1)>(vb), l3 = tr_read<v_rd_off(D0, 3, 0)>(vb), h3 = tr_read<v_rd_off(D0, 3, 1)>(vb);
  asm volatile("s_waitcnt lgkmcnt(0)" ::: "memory"); SBAR();
#define PK(L, H) (bf16x8){L[0], L[1], L[2], L[3], H[0], H[1], H[2], H[3]}
  od = __builtin_amdgcn_mfma_f32_32x32x16_bf16(pa0, PK(l0, h0), od, 0, 0, 0);
  od = __builtin_amdgcn_mfma_f32_32x32x16_bf16(pa1, PK(l1, h1), od, 0, 0, 0);
  od = __builtin_amdgcn_mfma_f32_32x32x16_bf16(pa2, PK(l2, h2), od, 0, 0, 0);
  od = __builtin_amdgcn_mfma_f32_32x32x16_bf16(pa3, PK(l3, h3), od, 0, 0, 0);
#undef PK
}
__device__ __forceinline__ void pv_d0(f32x16* o, int vb, bf16x8 pa0, bf16x8 pa1, bf16x8 pa2, bf16x8 pa3) {
  pv_one<0>(o[0], vb, pa0, pa1, pa2, pa3); pv_one<1>(o[1], vb, pa0, pa1, pa2, pa3); pv_one<2>(o[2], vb, pa0, pa1, pa2, pa3); pv_one<3>(o[3], vb, pa0, pa1, pa2, pa3);
}
__device__ __forceinline__ void attn_dense_body(const bf16_t* __restrict__ Qb, const bf16_t* __restrict__ Kh, const bf16_t* __restrict__ Vh,
                                                bf16_t* __restrict__ Ob, int seq, int ldq, int ldk, int ldo, char* lds, const float* __restrict__ qn, const float* __restrict__ rope0) {
  const int tid = tid_fresh(), wid = tid >> 6, lane = tid & 63, r32 = lane & 31, hi = lane >> 5;
  char* V_lds = lds; char* K_lds = lds + 2 * SHM_V;
  float* ws = (float*)(lds + 2 * SHM_V + 2 * SHM_K) + wid * 64; float* li_l = ws; float* al_l = ws + 32;
  float m_reg = -1e30f, l_reg = 0; f32x16 o[4] = {}; bf16x8 qr[8];
  const bf16_t* Qw = Qb + (long)(wid * QBLK + r32) * ldq + hi * 8;
#pragma unroll
  for (int d0 = 0; d0 < 8; ++d0) qr[d0] = *reinterpret_cast<const bf16x8*>(Qw + d0 * 16);
  {
    float qf[8][8]; float ss = 0.f;
#pragma unroll
    for (int d0 = 0; d0 < 8; ++d0)
#pragma unroll
      for (int e = 0; e < 8; ++e) { qf[d0][e] = bf2f((unsigned short)qr[d0][e]); ss += qf[d0][e] * qf[d0][e]; }
    ss += __shfl_xor(ss, 32);
    const float rstd = 1.0f / sqrtf(ss * (1.0f / D) + EPS);
#pragma unroll
    for (int d0 = 0; d0 < 8; ++d0) { const f32x4 g0 = *(const f32x4*)(qn + d0 * 16 + hi * 8), g1 = *(const f32x4*)(qn + d0 * 16 + hi * 8 + 4);
#pragma unroll
      for (int e = 0; e < 8; ++e) qf[d0][e] *= rstd * (e < 4 ? g0[e & 3] : g1[e & 3]); }
    if (rope0 != nullptr) { const float* rp = rope0 + (long)(wid * QBLK + r32) * 128 + hi * 8;
#pragma unroll
      for (int ax = 0; ax < 2; ++ax)
#pragma unroll
        for (int dl = 0; dl < 2; ++dl) { const int d0 = 4 * ax + dl;
          const f32x4 c0 = *(const f32x4*)(rp + ax * 64 + dl * 16), c1 = *(const f32x4*)(rp + ax * 64 + dl * 16 + 4), s0 = *(const f32x4*)(rp + ax * 64 + 32 + dl * 16), s1 = *(const f32x4*)(rp + ax * 64 + 32 + dl * 16 + 4);
#pragma unroll
          for (int e = 0; e < 8; ++e) { const float c = e < 4 ? c0[e & 3] : c1[e & 3], sn = e < 4 ? s0[e & 3] : s1[e & 3]; const float x1 = qf[d0][e], x2 = qf[d0 + 2][e];
            qf[d0][e] = x1 * c - x2 * sn; qf[d0 + 2][e] = x2 * c + x1 * sn; } } }
#pragma unroll
    for (int d0 = 0; d0 < 8; ++d0) { u32x4 w; w.x = cvt_pk_bf16(qf[d0][0], qf[d0][1]); w.y = cvt_pk_bf16(qf[d0][2], qf[d0][3]); w.z = cvt_pk_bf16(qf[d0][4], qf[d0][5]); w.w = cvt_pk_bf16(qf[d0][6], qf[d0][7]);
      qr[d0] = __builtin_bit_cast(bf16x8, w); }
  }
  const int sr = tid >> 4, sc = (tid & 15) * 8, vst0 = v_st(sr, sc), vst1 = v_st(32 + sr, sc);
  const int vb0 = (int)(uintptr_t)V_lds + v_rd_base(lane);
  bf16x8 e_vs0, e_vs1, e_ks0, e_ks1, o_vs0, o_vs1, o_ks0, o_ks1;
#define SLOAD_E(k0) do { e_vs0 = *reinterpret_cast<const bf16x8*>(&Vh[(long)((k0) + sr) * ldk + sc]); e_vs1 = *reinterpret_cast<const bf16x8*>(&Vh[(long)((k0) + 32 + sr) * ldk + sc]); \
    e_ks0 = *reinterpret_cast<const bf16x8*>(&Kh[(long)((k0) + sr) * ldk + sc]); e_ks1 = *reinterpret_cast<const bf16x8*>(&Kh[(long)((k0) + 32 + sr) * ldk + sc]); } while (0)
#define SLOAD_O(k0) do { o_vs0 = *reinterpret_cast<const bf16x8*>(&Vh[(long)((k0) + sr) * ldk + sc]); o_vs1 = *reinterpret_cast<const bf16x8*>(&Vh[(long)((k0) + 32 + sr) * ldk + sc]); \
    o_ks0 = *reinterpret_cast<const bf16x8*>(&Kh[(long)((k0) + sr) * ldk + sc]); o_ks1 = *reinterpret_cast<const bf16x8*>(&Kh[(long)((k0) + 32 + sr) * ldk + sc]); } while (0)
#define SWRITE_E(b) do { *(bf16x8*)(V_lds + (b) * SHM_V + vst0) = e_vs0; *(bf16x8*)(V_lds + (b) * SHM_V + vst1) = e_vs1; int kc = sc * 2; \
    *(bf16x8*)(K_lds + (b) * SHM_K + KSWZ(sr, kc)) = e_ks0; *(bf16x8*)(K_lds + (b) * SHM_K + KSWZ(32 + sr, kc)) = e_ks1; } while (0)
#define SWRITE_O(b) do { *(bf16x8*)(V_lds + (b) * SHM_V + vst0) = o_vs0; *(bf16x8*)(V_lds + (b) * SHM_V + vst1) = o_vs1; int kc = sc * 2; \
    *(bf16x8*)(K_lds + (b) * SHM_K + KSWZ(sr, kc)) = o_ks0; *(bf16x8*)(K_lds + (b) * SHM_K + KSWZ(32 + sr, kc)) = o_ks1; } while (0)
#define SWAIT() asm volatile("s_waitcnt vmcnt(4)" ::: "memory")
#define RESC(a) do { if (__any((a) < 1.f)) { if (hi == 0) al_l[r32] = (a); asm volatile("s_waitcnt lgkmcnt(0)" ::: "memory"); \
    _Pragma("unroll") for (int d = 0; d < 4; ++d) _Pragma("unroll") for (int r = 0; r < 16; ++r) o[d][r] *= al_l[crow(r, hi)]; } } while (0)
  f32x16 pA0, pA1, pB0, pB1; float mnA, mnB, alA, alB; bf16x8 pa0, pa1, pa2, pa3; const int NT = seq / KVBLK;
  SLOAD_E(0); asm volatile("s_waitcnt vmcnt(0)" ::: "memory"); SWRITE_E(0); __syncthreads();
  qkt(pA0, pA1, K_lds, qr, r32, hi); partialSM(pA0, pA1, m_reg, mnA, alA);
  SLOAD_O(KVBLK); if (2 < NT) SLOAD_E(2 * KVBLK);
  SWAIT(); SWRITE_O(1); __syncthreads();
  for (int j = 1; j + 1 < NT; j += 2) {
    SBAR(); qkt(pB0, pB1, K_lds + SHM_K, qr, r32, hi);
    finishSM(pA0, pA1, alA, l_reg, pa0, pa1, pa2, pa3); SBAR();
    SLOAD_O((j + 2) * KVBLK); SBAR();
    pv_d0(o, vb0, pa0, pa1, pa2, pa3); partialSM(pB0, pB1, m_reg, mnB, alB);
    __syncthreads(); SWAIT(); SWRITE_E(0);
    RESC(alB); __syncthreads();
    SBAR(); qkt(pA0, pA1, K_lds, qr, r32, hi);
    finishSM(pB0, pB1, alB, l_reg, pa0, pa1, pa2, pa3); SBAR();
    if (j + 3 < NT) SLOAD_E((j + 3) * KVBLK); SBAR();
    pv_d0(o, vb0 + (int)SHM_V, pa0, pa1, pa2, pa3); partialSM(pA0, pA1, m_reg, mnA, alA);
    __syncthreads(); SWAIT(); SWRITE_O(1);
    RESC(alA); __syncthreads();
  }
  SBAR(); qkt(pB0, pB1, K_lds + SHM_K, qr, r32, hi);
  finishSM(pA0, pA1, alA, l_reg, pa0, pa1, pa2, pa3); SBAR();
  pv_d0(o, vb0, pa0, pa1, pa2, pa3); partialSM(pB0, pB1, m_reg, mnB, alB);
  __syncthreads(); RESC(alB);
  finishSM(pB0, pB1, alB, l_reg, pa0, pa1, pa2, pa3); SBAR();
  pv_d0(o, vb0 + (int)SHM_V, pa0, pa1, pa2, pa3);
  if (hi == 0) li_l[r32] = l_reg; asm volatile("s_waitcnt lgkmcnt(0)" ::: "memory");
  float rli[16];
#pragma unroll
  for (int r = 0; r < 16; ++r) rli[r] = __builtin_amdgcn_rcpf(li_l[crow(r, hi)]);
  bf16_t* Ow = Ob + (long)(wid * QBLK) * ldo;
#pragma unroll
  for (int r = 0; r < 16; ++r) { int orow = crow(r, hi);
#pragma unroll
    for (int d0 = 0; d0 < 4; ++d0) Ow[(long)orow * ldo + d0 * 32 + r32] = (bf16_t)(cvt_pk_bf16(o[d0][r] * rli[r], 0.f) & 0xffffu); }
#undef SLOAD_E
#undef SLOAD_O
#undef SWRITE_E
#undef SWRITE_O
#undef SWAIT
#undef RESC
}
}

#define XB_TMO      128
#define XB_XCNT(j)  (256  + 64 * (j))
#define XB_XSUB(j)  (1280 + 64 * (j))
#define XB_XGEN(j)  (2304 + 64 * (j))
#define XB_TOP      3328
#define XB_TOPGEN   3392
#define XCD_BAR_WORDS 3456
#define XB_SPIN_CAP (1u << 18)
__device__ __forceinline__ unsigned xb_ld(unsigned* p)              { return __hip_atomic_load(p, __ATOMIC_RELAXED, __HIP_MEMORY_SCOPE_AGENT); }
__device__ __forceinline__ unsigned xb_add(unsigned* p, unsigned v) { return __hip_atomic_fetch_add(p, v, __ATOMIC_RELAXED, __HIP_MEMORY_SCOPE_AGENT); }
__device__ __forceinline__ unsigned xb_xcc_id() { return (unsigned)__builtin_amdgcn_s_getreg((3 << 11) | 20) & 0xFu; }
#define XB_SPIN(cond, bar) do { unsigned _sp = 0; while (cond) { __builtin_amdgcn_s_sleep(1); \
    if ((++_sp & 255u) == 0u) { if (xb_ld(&(bar)[XB_TMO])) break; if (_sp > XB_SPIN_CAP) { atomicAdd(&(bar)[XB_TMO], 1u); break; } } } } while (0)
struct XcdBarrier { unsigned* bar; unsigned x; volatile LAS unsigned* st; };
__device__ __forceinline__ XcdBarrier xcd_barrier_post(unsigned* bar, volatile LAS unsigned* st) {
    XcdBarrier b; b.bar = bar; b.x = xb_xcc_id(); b.st = st;
    if (threadIdx.x == 0) (void)xb_add(&bar[XB_XCNT(b.x)], 1u);
    return b;
}
__device__ __forceinline__ void xcd_barrier_complete(unsigned* bar, unsigned x, unsigned& nloc, unsigned& nx) {
    const unsigned G = gridDim.x * gridDim.y * gridDim.z;
    unsigned sum, cnt, mine, sp = 0u;
    for (;;) {
        sum = 0u; cnt = 0u; mine = 0u;
#pragma unroll
        for (unsigned j = 0; j < 16; ++j) { const unsigned c = xb_ld(&bar[XB_XCNT(j)]); sum += c; cnt += (c > 0u) ? 1u : 0u; mine = (j == x) ? c : mine; }
        if (sum == G) break;
        __builtin_amdgcn_s_sleep(1);
        if ((++sp & 255u) == 0u) { if (xb_ld(&bar[XB_TMO])) break; if (sp > XB_SPIN_CAP) { atomicAdd(&bar[XB_TMO], 1u); break; } }
    }
    nloc = mine > 0u ? mine : 1u; nx = cnt > 0u ? cnt : 1u;
}
__device__ __forceinline__ void xcd_barrier(const XcdBarrier& b) {
    asm volatile("s_waitcnt vmcnt(0)" ::: "memory");
    __syncthreads();
    if (threadIdx.x == 0) {
        unsigned* bar = b.bar;
        __builtin_amdgcn_s_waitcnt(0);
        unsigned nloc = b.st[0], nx = b.st[1];
        if (nloc == 0u) { xcd_barrier_complete(bar, b.x, nloc, nx); b.st[0] = nloc; b.st[1] = nx; }
        const unsigned old = xb_add(&bar[XB_XSUB(b.x)], 1u);
        const unsigned gen = old / nloc;
        if (old + 1u == (gen + 1u) * nloc) {
            __builtin_amdgcn_fence(__ATOMIC_RELEASE, "agent");
            asm volatile("s_waitcnt vmcnt(0)" ::: "memory");
            const unsigned og = xb_add(&bar[XB_TOP], 1u);
            const unsigned tg = og / nx;
            if (og + 1u == (tg + 1u) * nx) xb_add(&bar[XB_TOPGEN], 1u);
            else XB_SPIN(xb_ld(&bar[XB_TOPGEN]) == tg, bar);
            __builtin_amdgcn_fence(__ATOMIC_ACQUIRE, "agent");
            xb_add(&bar[XB_XGEN(b.x)], 1u);
            asm volatile("s_waitcnt vmcnt(0)" ::: "memory");
        } else {
            XB_SPIN(xb_ld(&bar[XB_XGEN(b.x)]) == gen, bar);
            __builtin_amdgcn_fence(__ATOMIC_ACQUIRE, "agent");
            asm volatile("s_waitcnt vmcnt(0)" ::: "memory");
        }
    }
    __syncthreads();
}

struct Args {
    const float* x_prompt; const float* x_sample; const float* cache_k; const float* cache_v; const float* st_f; const float* st_b; const float* c; const float* c_ctx;
    const float* w_mod; const float* b_mod; const float* norm1; const float* w_in; const float* q_norm; const float* k_norm; const float* wg_f; const float* bg_f;
    const float* wg_b; const float* bg_b; const float* gla_norm; const float* w_out; const float* norm2; const float* w_up; const float* w_down;
    float* out; unsigned char* ws; int ph_lo, ph_hi;
};
static_assert(sizeof(Args) == 25 * 8 + 8, "Args has no padding");
typedef const __attribute__((address_space(4))) Args* KArgsP;
__device__ __forceinline__ KArgsP ka_get() { KArgsP p = (KArgsP)__builtin_amdgcn_kernarg_segment_ptr(); asm volatile("" : "+s"(p)); return p; }
__device__ __forceinline__ float* mk_out_ptr() { return ka_get()->out; }

__device__ __forceinline__ float wave_sum(float v) {
#pragma unroll
    for (int o = 1; o < 64; o <<= 1) v += __shfl_xor(v, o);
    return v;
}
__device__ __forceinline__ float half_sum(float v) {
#pragma unroll
    for (int o = 1; o < 32; o <<= 1) v += __shfl_xor(v, o);
    return v;
}
__device__ __forceinline__ float silu_f(float x) { return x / (1.f + __expf(-x)); }
__device__ __forceinline__ float logsigmoid_f(float z) { return fminf(z, 0.f) - log1pf(__expf(-fabsf(z))); }

__device__ __forceinline__ int win_row(int ncol) {
    if (ncol >= C_QG && ncol < C_KG) return C_QG + ((ncol - C_QG) >> 6) * 256 + ((ncol - C_QG) & 63);
    if (ncol >= C_KG && ncol < C_VG) return C_QG + ((ncol - C_KG) >> 6) * 256 + 64 + ((ncol - C_KG) & 63);
    if (ncol >= C_VG && ncol < C_OG) return C_QG + ((ncol - C_VG) >> 7) * 256 + 128 + ((ncol - C_VG) & 127);
    if (ncol < C_K || ncol >= C_V) return ncol;
    const int hh = (ncol - C_K) >> 7, d = (ncol - C_K) & 127, half64 = d >> 6, r = d & 63, nn = r >> 5, r5 = r & 31, g = half64 * 8 + (r5 >> 2), j = r5 & 3;
    return C_K + hh * 128 + 32 * (g >> 2) + 8 * (g & 3) + 4 * nn + j;
}
template <bool REMAP>
__device__ __forceinline__ void p0_transpose_item(const float* W, int K, int N, bf16_t* WT, LAS float* scr, int item, int lane) {
    const int nblk = N / 32, kb = item / nblk, nb = item % nblk, k0 = 64 * kb, n0 = 32 * nb;
#pragma unroll 8
    for (int i = 0; i < 32; ++i) { const int kk = 2 * i + (lane >> 5); scr[kk * 33 + (lane & 31)] = PRO_NT ? __builtin_nontemporal_load(&W[(size_t)(k0 + kk) * N + n0 + (lane & 31)]) : W[(size_t)(k0 + kk) * N + n0 + (lane & 31)]; }
    LDS_WAIT(); asm volatile("" ::: "memory");
    const int c = lane & 7;
#pragma unroll
    for (int j = 0; j < 4; ++j) { const int n = (lane >> 3) + 8 * j; const LAS float* s = scr + (8 * c) * 33 + n;
        u32x4 o; o.x = pk2(s[0 * 33], s[1 * 33]); o.y = pk2(s[2 * 33], s[3 * 33]); o.z = pk2(s[4 * 33], s[5 * 33]); o.w = pk2(s[6 * 33], s[7 * 33]);
        if (PRO_NT) __builtin_nontemporal_store(o, (u32x4*)(WT + (size_t)(REMAP ? win_row(n0 + n) : n0 + n) * K + k0 + 8 * c)); else *(u32x4*)(WT + (size_t)(REMAP ? win_row(n0 + n) : n0 + n) * K + k0 + 8 * c) = o; }
    LDS_WAIT(); asm volatile("" ::: "memory");
}

constexpr int CW_IN = (DM / 64) * (PROJ_W / 32), CW_OUT = (DM / 64) * (DM / 32), CW_UP = (DM / 64) * (DFF / 32), CW_DN = (DFF / 64) * (DM / 32), CW_IL = CW_IN + CW_OUT + CW_UP + CW_DN;
__device__ __forceinline__ void convert_weights(KArgsP ap, LAS unsigned char* lds, int lo, int hi, int part, int nparts) {
    const int tid = tid_fresh(), lane = tid & 63, wave = __builtin_amdgcn_readfirstlane(tid >> 6);
    unsigned char* ws = ap->ws;
    LAS float* scr = (LAS float*)(lds + wave * 16384);
    for (int it = lo + part * 8 + wave; it < hi; it += nparts * 8) {
        const int l = it / CW_IL; int r = it % CW_IL;
        if (r < CW_IN) { p0_transpose_item<true>(ap->w_in + (size_t)l * DM * PROJ_W, DM, PROJ_W, (bf16_t*)(ws + WS_WIN) + (size_t)l * PROJ_P * DM, scr, r, lane); continue; } r -= CW_IN;
        if (r < CW_OUT) { p0_transpose_item<false>(ap->w_out + (size_t)l * DM * DM, DM, DM, (bf16_t*)(ws + WS_WOUT) + (size_t)l * DM * DM, scr, r, lane); continue; } r -= CW_OUT;
        if (r < CW_UP) { p0_transpose_item<false>(ap->w_up + (size_t)l * DM * DFF, DM, DFF, (bf16_t*)(ws + WS_WUP) + (size_t)l * DFF * DM, scr, r, lane); continue; } r -= CW_UP;
        p0_transpose_item<false>(ap->w_down + (size_t)l * DFF * DM, DFF, DM, (bf16_t*)(ws + WS_WDN) + (size_t)l * DM * DFF, scr, r, lane);
    }
}

__device__ __forceinline__ void phase_prologue(KArgsP ap, LAS unsigned char* lds, int G) {
    const int tid = tid_fresh(), lane = tid & 63, wave = __builtin_amdgcn_readfirstlane(tid >> 6);
    unsigned char* ws = ap->ws;
    float* MOD = (float*)(ws + WS_MOD);
    {
        LAS float* sv = (LAS float*)lds;
        LAS float* red = (LAS float*)(lds + 40960);
        for (int i = tid; i < NGRP * DM; i += 512) { const int v = i / DM, k = i % DM; const float x = (v == 0) ? ap->c_ctx[k] : ap->c[(v - 1) * DM + k]; sv[i] = silu_f(x); }
        __syncthreads();
        const int kg = tid >> 4, cl = tid & 15;
        for (int it = blockIdx.x; it < DEPTH * (6 * DM / 64); it += G) {
            const int l = it / (6 * DM / 64), n0 = (it % (6 * DM / 64)) * 64;
            const float* wp = ap->w_mod + ((size_t)l * DM + kg * 64) * (6 * DM) + n0 + 4 * cl;
            f32x4 acc[NGRP];
#pragma unroll
            for (int v = 0; v < NGRP; ++v) acc[v] = (f32x4){0.f, 0.f, 0.f, 0.f};
#pragma unroll 8
            for (int kk = 0; kk < 64; ++kk) { const f32x4 w = PRO_NT ? __builtin_nontemporal_load((const f32x4*)(wp + (size_t)kk * (6 * DM))) : *(const f32x4*)(wp + (size_t)kk * (6 * DM));
#pragma unroll
                for (int v = 0; v < NGRP; ++v) acc[v] += w * sv[v * DM + kg * 64 + kk]; }
#pragma unroll
            for (int v = 0; v < NGRP; ++v) *(LAS f32x4*)(red + (kg * NGRP + v) * 64 + 4 * cl) = acc[v];
            __syncthreads();
            if (tid < NGRP * 64) { const int v = tid >> 6, n = tid & 63; float s = 0.f;
                for (int g2 = 0; g2 < 32; ++g2) s += red[(g2 * NGRP + v) * 64 + n];
                MOD[((size_t)l * NGRP + v) * (6 * DM) + n0 + n] = s + ap->b_mod[(size_t)l * (6 * DM) + n0 + n]; }
            __syncthreads();
        }
    }
    __syncthreads();
    const int gw = blockIdx.x * 8 + wave, NGW = G * 8;
    const size_t gt = (size_t)blockIdx.x * 512 + tid, NGT = (size_t)G * 512;
    convert_weights(ap, lds, 0, (CONV_TAILS ? 2 : 4) * CW_IL, blockIdx.x, G);
    {
        constexpr size_t PADV = (size_t)(PROJ_P - PROJ_W) * DM * 2 / 16;
        for (size_t i = gt; i < DEPTH * PADV; i += NGT) { const size_t l = i / PADV, r = i % PADV;
            *(u32x4*)(ws + WS_WIN + (l * PROJ_P + PROJ_W) * (size_t)DM * 2 + r * 16) = (u32x4){0u, 0u, 0u, 0u}; }
    }
    {
        float* RP = (float*)(ws + WS_ROPE);
        for (size_t i = gt; i < (size_t)S_LAT * 64; i += NGT) { const int t = (int)(i >> 6), j = (int)(i & 63), ax = j >> 5, fi = j & 31;
            const float pos = (float)(ax == 0 ? (t >> 6) : (t & 63));
            const float inv = exp2f(-(float)fi * (13.287712379549449f / 32.f));
            const float rev = pos * inv * 0.15915494309189535f; const float fr = rev - floorf(rev);
            RP[(size_t)t * 128 + ax * 64 + fi] = __builtin_amdgcn_cosf(fr); RP[(size_t)t * 128 + ax * 64 + 32 + fi] = __builtin_amdgcn_sinf(fr); }
    }
    {
        constexpr size_t NV = (size_t)NB_LAT * DEPTH * PAST * KVW / 4;
        for (size_t i = gt; i < 2 * NV; i += NGT) { const bool isv = i >= NV; const size_t j = isv ? i - NV : i;
            const size_t e = j * 4, b = e / ((size_t)DEPTH * PAST * KVW), rem = e % ((size_t)DEPTH * PAST * KVW), l = rem / ((size_t)PAST * KVW), sc = rem % ((size_t)PAST * KVW);
            const f32x4 v = *(const f32x4*)((isv ? ap->cache_v : ap->cache_k) + e);
            u32x2 o; o.x = pk2(v[0], v[1]); o.y = pk2(v[2], v[3]);
            *(u32x2*)((bf16_t*)(ws + (isv ? WS_VL : WS_KL)) + ((l * NB_LAT + b) * S_KVL) * KVW + sc) = o; }
    }
}

__device__ __forceinline__ void phase_norm(bf16_t* XB, const bf16_t* side, const float* nw, const float* mod_l  , int off_shift, int off_scale, bf16_t* H, int G, bool from_inputs = false) {
    const int tid = tid_fresh(), lane = tid & 63, wave = __builtin_amdgcn_readfirstlane(tid >> 6);
    const int gw = blockIdx.x * 8 + wave, NGW = G * 8;
    constexpr int RB = 3;
    int cur_grp = -1; f32x4 gm[4][2], sh[4][2];
    for (int row = gw * RB; row < M; row += NGW * RB) {
        u32x4 xv[RB][4];
        if (from_inputs) {
            KArgsP ka = ka_get();
#pragma unroll
            for (int rr = 0; rr < RB; ++rr) { const int r = row + rr; const float* src = (r < M_CTX ? ka->x_prompt + (size_t)r * DM : ka->x_sample + (size_t)(r - M_CTX) * DM) + 8 * lane;
                f32x4 fa[4], fb[4];
#pragma unroll
                for (int j = 0; j < 4; ++j) { fa[j] = __builtin_nontemporal_load((const f32x4*)(src + 512 * j)); fb[j] = __builtin_nontemporal_load((const f32x4*)(src + 512 * j + 4)); }
#pragma unroll
                for (int j = 0; j < 4; ++j) { u32x4 w; w.x = cvt_pk_bf16(fa[j][0], fa[j][1]); w.y = cvt_pk_bf16(fa[j][2], fa[j][3]); w.z = cvt_pk_bf16(fb[j][0], fb[j][1]); w.w = cvt_pk_bf16(fb[j][2], fb[j][3]);
                    xv[rr][j] = w; *(u32x4*)(XB + (size_t)r * DM + 8 * lane + 512 * j) = w; } } }
        else {
#pragma unroll
        for (int rr = 0; rr < RB; ++rr)
#pragma unroll
            for (int j = 0; j < 4; ++j) xv[rr][j] = *(const u32x4*)(XB + (size_t)(row + rr) * DM + 8 * lane + 512 * j); }
        if (side != nullptr && row + RB > M_CTX) {
#pragma unroll
            for (int rr = 0; rr < RB; ++rr) { const int r = row + rr;
                if (r >= M_CTX) {
#pragma unroll
                    for (int j = 0; j < 4; ++j) { const u32x4 sv = __builtin_nontemporal_load((const u32x4*)(side + (size_t)(r - M_CTX) * DM + 8 * lane + 512 * j)); u32x4 w = xv[rr][j];
                        w.x = cvt_pk_bf16(bflo(w.x) + bflo(sv.x), bfhi(w.x) + bfhi(sv.x)); w.y = cvt_pk_bf16(bflo(w.y) + bflo(sv.y), bfhi(w.y) + bfhi(sv.y));
                        w.z = cvt_pk_bf16(bflo(w.z) + bflo(sv.z), bfhi(w.z) + bfhi(sv.z)); w.w = cvt_pk_bf16(bflo(w.w) + bflo(sv.w), bfhi(w.w) + bfhi(sv.w));
                        xv[rr][j] = w; *(u32x4*)(XB + (size_t)r * DM + 8 * lane + 512 * j) = w; } } } }
#pragma unroll
        for (int rr = 0; rr < RB; ++rr) { const int r = row + rr;
            const int grp = r < M_CTX ? 0 : 1 + (r - M_CTX) / S_LAT;
            if (grp != cur_grp) { cur_grp = grp; const float* mp = mod_l + (size_t)grp * (6 * DM);
#pragma unroll
                for (int j = 0; j < 4; ++j)
#pragma unroll
                    for (int q = 0; q < 2; ++q) { const int c = 8 * lane + 512 * j + 4 * q; const f32x4 w = *(const f32x4*)(nw + c), sc = *(const f32x4*)(mp + off_scale + c);
                        gm[j][q] = w * (sc + 1.0f); sh[j][q] = *(const f32x4*)(mp + off_shift + c); } }
            float x[4][8]; float ss = 0.f;
#pragma unroll
            for (int j = 0; j < 4; ++j) { const u32x4 w = xv[rr][j];
                x[j][0] = bflo(w.x); x[j][1] = bfhi(w.x); x[j][2] = bflo(w.y); x[j][3] = bfhi(w.y); x[j][4] = bflo(w.z); x[j][5] = bfhi(w.z); x[j][6] = bflo(w.w); x[j][7] = bfhi(w.w);
#pragma unroll
                for (int e = 0; e < 8; ++e) ss += x[j][e] * x[j][e]; }
            const float rstd = 1.0f / sqrtf(wave_sum(ss) * (1.0f / DM) + EPS);
            bf16_t* hr = H + (size_t)r * DM;
#pragma unroll
            for (int j = 0; j < 4; ++j) { float y[8];
#pragma unroll
                for (int e = 0; e < 8; ++e) y[e] = x[j][e] * rstd * gm[j][e >> 2][e & 3] + sh[j][e >> 2][e & 3];
                u32x4 o; o.x = cvt_pk_bf16(y[0], y[1]); o.y = cvt_pk_bf16(y[2], y[3]); o.z = cvt_pk_bf16(y[4], y[5]); o.w = cvt_pk_bf16(y[6], y[7]);
                *(u32x4*)(hr + 8 * lane + 512 * j) = o; }
        }
    }
}

__device__ __forceinline__ void phase_prep(KArgsP a, int l, int G, int dry) {
    const int tid = tid_fresh(), lane = tid & 63, wave = __builtin_amdgcn_readfirstlane(tid >> 6);
    unsigned char* ws = a->ws;
    bf16_t* PROJ = (bf16_t*)(ws + WS_PROJ);
    const float* RP = (const float*)(ws + WS_ROPE);
    const int gw = blockIdx.x * 8 + wave, NGW = G * 8;
    const int j16 = lane & 15, sg = lane >> 4, d0 = 8 * j16;
    f32x4 gq[2], gk[2];
    { const float* qn = a->q_norm + l * HD + d0; const float* kn = a->k_norm + l * HD + d0; gq[0] = *(const f32x4*)qn; gq[1] = *(const f32x4*)(qn + 4); gk[0] = *(const f32x4*)kn; gk[1] = *(const f32x4*)(kn + 4); }
    const float sgn = (j16 & 4) ? 1.f : -1.f;
    const int rpo = (j16 >> 3) * 64 + 8 * (j16 & 3);
    float* out = a->out;
    constexpr int RB = 2;
    for (int row = gw * RB; row < M; row += NGW * RB) {
        u32x4 wv[RB][3]; f32x4 rc[RB][2], rs[RB][2];
#pragma unroll
        for (int rr = 0; rr < RB; ++rr) { const int r = row + rr; const bf16_t* pr = PROJ + (size_t)r * PROJ_P;
#pragma unroll
            for (int it = 2; it < 3; ++it) wv[rr][it] = *(const u32x4*)(pr + (4 * it + sg) * HD + d0);
            if (r >= M_CTX) { const float* rp = RP + (size_t)((r - M_CTX) % S_LAT) * 128 + rpo; rc[rr][0] = *(const f32x4*)rp; rc[rr][1] = *(const f32x4*)(rp + 4); rs[rr][0] = *(const f32x4*)(rp + 32); rs[rr][1] = *(const f32x4*)(rp + 36); }
            else { rc[rr][0] = rc[rr][1] = (f32x4){1.f, 1.f, 1.f, 1.f}; rs[rr][0] = rs[rr][1] = (f32x4){0.f, 0.f, 0.f, 0.f}; } }
#pragma unroll
        for (int rr = 0; rr < RB; ++rr) { const int r = row + rr; bf16_t* pr = PROJ + (size_t)r * PROJ_P;
            const bool lat = r >= M_CTX;
            int b, t; if (!lat) { b = r / S_CTX; t = r % S_CTX; } else { b = (r - M_CTX) / S_LAT; t = (r - M_CTX) % S_LAT; }
            bf16_t* kdst = lat ? (bf16_t*)(ws + WS_KL) + ((size_t)(l * NB_LAT + b) * S_KVL + PAST + t) * KVW : (bf16_t*)(ws + WS_KC) + (size_t)r * KVW;
            bf16_t* vdst = lat ? (bf16_t*)(ws + WS_VL) + ((size_t)(l * NB_LAT + b) * S_KVL + PAST + t) * KVW : (bf16_t*)(ws + WS_VC) + (size_t)r * KVW;
            float* ckout = out + OUT_CK + (((size_t)b * DEPTH + l) * S_CTX + t) * KVW;
            float* cvout = out + OUT_CV + (((size_t)b * DEPTH + l) * S_CTX + t) * KVW;
#pragma unroll
            for (int it = 2; it < 3; ++it) {
                const int slot = 4 * it + sg;
                const u32x4 w = wv[rr][it];
                float x[8] = {bflo(w.x), bfhi(w.x), bflo(w.y), bfhi(w.y), bflo(w.z), bfhi(w.z), bflo(w.w), bfhi(w.w)};
                if (it == 2 && sg >= 2) {
                    if (!dry) *(u32x4*)(vdst + (slot - 10) * HD + d0) = w;
                    if (!lat && !dry) { *(f32x4*)(cvout + (slot - 10) * HD + d0) = (f32x4){x[0], x[1], x[2], x[3]}; *(f32x4*)(cvout + (slot - 10) * HD + d0 + 4) = (f32x4){x[4], x[5], x[6], x[7]}; }
                }
                float ss = 0.f;
#pragma unroll
                for (int e = 0; e < 8; ++e) ss += x[e] * x[e];
                ss += __shfl_xor(ss, 1); ss += __shfl_xor(ss, 2); ss += __shfl_xor(ss, 4); ss += __shfl_xor(ss, 8);
                const float rstd = 1.0f / sqrtf(ss * (1.0f / HD) + EPS);
                const bool isk = (it == 2);
                float y[8], z[8];
#pragma unroll
                for (int e = 0; e < 8; ++e) y[e] = x[e] * rstd * (isk ? gk[e >> 2][e & 3] : gq[e >> 2][e & 3]);
#pragma unroll
                for (int e = 0; e < 8; ++e) { const float p = __shfl_xor(y[e], 4); z[e] = y[e] * rc[rr][e >> 2][e & 3] + sgn * p * rs[rr][e >> 2][e & 3]; }
                u32x4 o; o.x = cvt_pk_bf16(z[0], z[1]); o.y = cvt_pk_bf16(z[2], z[3]); o.z = cvt_pk_bf16(z[4], z[5]); o.w = cvt_pk_bf16(z[6], z[7]);
                if (dry) { if (o.x == 0x12345678u && o.y == 0x9abcdef0u) *(u32x4*)(pr + slot * HD + d0) = o; }
                else if (it < 2) *(u32x4*)(pr + slot * HD + d0) = o;
                else if (sg < 2) { *(u32x4*)(kdst + (slot - 8) * HD + d0) = o;
                    if (!lat) { *(f32x4*)(ckout + (slot - 8) * HD + d0) = (f32x4){y[0], y[1], y[2], y[3]}; *(f32x4*)(ckout + (slot - 8) * HD + d0 + 4) = (f32x4){y[4], y[5], y[6], y[7]}; } }
            }
        }
    }
}

__device__ __forceinline__ int dequeue(gu32* head, volatile LAS unsigned* slot, int tid) {
    __syncthreads();
    if (tid == 0) *slot = __hip_atomic_fetch_add((unsigned*)head, 1u, __ATOMIC_RELAXED, __HIP_MEMORY_SCOPE_AGENT);
    __syncthreads();
    return (int)*slot;
}

__device__ __forceinline__ void phase_attn(KArgsP a, int l, char* lds, gu32* head, volatile LAS unsigned* slot, int mode, int max_units) {
    const int tid = tid_fresh();
    unsigned char* ws = a->ws;
    const bf16_t* PROJ = (const bf16_t*)(ws + WS_PROJ); bf16_t* MIXA = (bf16_t*)(ws + WS_MIXA);
    const float* qnl = a->q_norm + l * HD;
    constexpr int N_LATU = NB_LAT * NQH * (S_LAT / 256), N_CTXU = NB_CTX * NQH;
    for (int nu = 0; nu < max_units; ++nu) {
        const int it = dequeue(head, slot, tid);
        if (it >= (mode == 0 ? N_LATU : N_CTXU)) break;
        int row0, h, seq; const bf16_t* kb; const bf16_t* vb;
        const float* rope0 = nullptr;
        if (mode == 0) { const int b = it / (NQH * 4), qb = it % 4; h = (it / 4) % NQH; row0 = M_CTX + b * S_LAT + qb * 256; seq = S_KVL; rope0 = (const float*)(ws + WS_ROPE) + (size_t)(qb * 256) * 128;
            kb = (const bf16_t*)(ws + WS_KL) + (size_t)(l * NB_LAT + b) * S_KVL * KVW + (h >> 2) * HD; vb = (const bf16_t*)(ws + WS_VL) + (size_t)(l * NB_LAT + b) * S_KVL * KVW + (h >> 2) * HD; }
        else { const int b = it / NQH; h = it % NQH; row0 = b * S_CTX; seq = S_CTX;
            kb = (const bf16_t*)(ws + WS_KC) + (size_t)row0 * KVW + (h >> 2) * HD; vb = (const bf16_t*)(ws + WS_VC) + (size_t)row0 * KVW + (h >> 2) * HD; }
        att::attn_dense_body(PROJ + (size_t)row0 * PROJ_P + C_Q + h * HD, kb, vb, MIXA + (size_t)row0 * DM + h * HD, seq, PROJ_P, KVW, DM, lds, qnl, rope0);
    }
}

constexpr int GL_QT = 0, GL_KT = 9216, GL_KH = 18432, GL_PP = 46080, GL_ST = 55296, GL_TOT = 73728, GL_RR = 75776, GL_DL = 79872, GL_VT = 81920  , GL_LD = 72;
__device__ __forceinline__ int crow16(int r, int hi) { return (r & 3) + 8 * (r >> 2) + 4 * hi; }
__device__ __forceinline__ unsigned short bf1(float x) { return (unsigned short)(cvt_pk_bf16(x, x) & 0xffffu); }
constexpr int N_GLA_LAT = NB_LAT * GH * 2, N_GLA_CTX = NB_CTX * GH * 2;
__device__ __forceinline__ void phase_gla(KArgsP a, int l, LAS unsigned char* lds, gu32* head, volatile LAS unsigned* slot, int mode, int G) {
    const int tid = tid_fresh(), lane = tid & 63, wave = __builtin_amdgcn_readfirstlane(tid >> 6);
    unsigned char* ws = a->ws;
    const bf16_t* PROJ = (const bf16_t*)(ws + WS_PROJ);
    LAS bf16_t* QT = (LAS bf16_t*)(lds + GL_QT); LAS bf16_t* KT = (LAS bf16_t*)(lds + GL_KT); LAS bf16_t* KH = (LAS bf16_t*)(lds + GL_KH);
    LAS bf16_t* VT = (LAS bf16_t*)(lds + GL_VT); LAS bf16_t* PP = (LAS bf16_t*)(lds + GL_PP); LAS bf16_t* ST = (LAS bf16_t*)(lds + GL_ST);
    LAS float* TOT = (LAS float*)(lds + GL_TOT); LAS float* RR = (LAS float*)(lds + GL_RR); LAS float* DL = (LAS float*)(lds + GL_DL);
    const int r32 = lane & 31, hi = lane >> 5;
    const int ste = wave >> 1, std_ = wave & 1;
    const int oti = wave >> 2, ote = wave & 3;
    int first = (mode == 0) ? (int)blockIdx.x : -1;
    int it_next = (mode == 1) ? N_GLA_LAT + dequeue(head, slot, tid) : 0;
    bool pre = false;
    float wgn[GRANK], bgn = 0.f;
    unsigned pr_r0, pr_v0[8], pr_r1, pr_v1[8], pr_q0[8], pr_k0[8], pr_q1[8], pr_k1[8];
    float qv[8], kv[8];
    const int gi_r = tid >> 3, qksh = 16 * (lane & 1);
    for (;;) {
        int it;
        if (mode == 0) { if (first < 0 || first >= N_GLA_LAT) break; it = first; first += G; }
        else { it = it_next; if (it >= N_GLA_LAT + N_GLA_CTX) break; }
        __syncthreads();
        unsigned nxt_v = 0u;
        if (mode == 1 && tid == 0) nxt_v = __hip_atomic_fetch_add((unsigned*)head, 1u, __ATOMIC_RELAXED, __HIP_MEMORY_SCOPE_AGENT);
        const bool lat = it < N_GLA_LAT; const int u = lat ? it : it - N_GLA_LAT;
        const int dir = u & 1, h = (u >> 1) % GH, b = u / (2 * GH);
        const int T = lat ? S_LAT : S_CTX, row_base = lat ? M_CTX + b * S_LAT : b * S_CTX, nch = T / 64;
        const __amdgpu_buffer_rsrc_t orsrc = __builtin_amdgcn_make_buffer_rsrc((void*)(ws + (dir ? WS_OB : WS_OF)), 0, (int)((size_t)M * 1024 * 2), 0x00020000);
        if (!pre) { const float* wgp = (dir ? a->wg_b : a->wg_f) + (size_t)l * GRANK * 512 + h * GDK + lane;
#pragma unroll
            for (int r = 0; r < GRANK; ++r) wgn[r] = wgp[r * 512];
            bgn = (dir ? a->bg_b : a->bg_f)[l * 512 + h * GDK + lane]; }
        s16x4 whi[GRANK / 4], wlo[GRANK / 4];
#pragma unroll
        for (int kk = 0; kk < GRANK / 4; ++kk) { float wv[4], wl[4]; u32x2 ph, pl;
#pragma unroll
            for (int q = 0; q < 4; ++q) wv[q] = wgn[4 * kk + q];
            ph.x = cvt_pk_bf16(wv[0], wv[1]); ph.y = cvt_pk_bf16(wv[2], wv[3]);
            wl[0] = wv[0] - bflo(ph.x); wl[1] = wv[1] - bfhi(ph.x); wl[2] = wv[2] - bflo(ph.y); wl[3] = wv[3] - bfhi(ph.y);
            pl.x = cvt_pk_bf16(wl[0], wl[1]); pl.y = cvt_pk_bf16(wl[2], wl[3]);
            whi[kk] = __builtin_bit_cast(s16x4, ph); wlo[kk] = __builtin_bit_cast(s16x4, pl); }
        const float bg = bgn;
        f32x16 sacc;
        if (lat) { const float* sp = (dir ? a->st_b : a->st_f) + (((size_t)b * DEPTH + l) * GH + h) * GDK * GDV + (size_t)(32 * std_ + 4 * hi) * GDV + 32 * ste + r32;
#pragma unroll
            for (int r = 0; r < 16; ++r) sacc[r] = sp[(size_t)((r & 3) + 8 * (r >> 2)) * GDV]; }
        else {
#pragma unroll
            for (int r = 0; r < 16; ++r) sacc[r] = 0.f; }
#pragma unroll
        for (int q = 0; q < 4; ++q) { u32x2 w; w.x = cvt_pk_bf16(sacc[4 * q], sacc[4 * q + 1]); w.y = cvt_pk_bf16(sacc[4 * q + 2], sacc[4 * q + 3]);
            *(LAS u32x2*)(ST + (32 * ste + r32) * GL_LD + 32 * std_ + 8 * q + 4 * hi) = w; }
        const __amdgpu_buffer_rsrc_t prsrc = __builtin_amdgcn_make_buffer_rsrc((void*)PROJ, 0, (int)((size_t)M * PROJ_P * 2), 0x00020000);
        const int voff_r = (dir ? 63 - gi_r : gi_r) * (PROJ_P * 2) + ((dir ? C_RB : C_RF) + (tid & 7) * 2) * 2;
        const int voff_v = (C_QG + h * 256 + 128 + 2 * lane) * 2, voff_q = (C_QG + h * 256 + (lane & ~1)) * 2, voff_k = (C_QG + h * 256 + 64 + (lane & ~1)) * 2;
#define GLA_LOADS(S_, c_, rb_, dir_, T_, vr_, vv_, vq_, vk_) do { const int low_ = (rb_) + ((dir_) ? ((T_) - 64 - 64 * (c_)) : 64 * (c_)); \
            pr_r##S_ = __builtin_amdgcn_raw_buffer_load_b32(prsrc, (vr_), low_ * (PROJ_P * 2), 0); \
            _Pragma("unroll") for (int tt = 0; tt < 8; ++tt) { const int so_ = (low_ + ((dir_) ? 63 - (8 * wave + tt) : (8 * wave + tt))) * (PROJ_P * 2); \
                pr_v##S_[tt] = __builtin_amdgcn_raw_buffer_load_b32(prsrc, (vv_), so_, 0); pr_q##S_[tt] = __builtin_amdgcn_raw_buffer_load_b32(prsrc, (vq_), so_, 0); pr_k##S_[tt] = __builtin_amdgcn_raw_buffer_load_b32(prsrc, (vk_), so_, 0); } } while (0)
#define GLA_LOADV(S_, v_) do { if ((v_) < nch) GLA_LOADS(S_, (v_), row_base, dir, T, voff_r, voff_v, voff_q, voff_k); \
            else if (mode == 1) { \
                if ((v_) == nch) { it_next = N_GLA_LAT + (int)*slot; nv = it_next < N_GLA_LAT + N_GLA_CTX;        \
                    if (nv) { const int un = it_next - N_GLA_LAT; dirn = un & 1; hn = (un >> 1) % GH; rbn = (un / (2 * GH)) * S_CTX; \
                        vrn = (dirn ? 63 - gi_r : gi_r) * (PROJ_P * 2) + ((dirn ? C_RB : C_RF) + (tid & 7) * 2) * 2; \
                        vvn = (C_QG + hn * 256 + 128 + 2 * lane) * 2; vqn = (C_QG + hn * 256 + (lane & ~1)) * 2; vkn = (C_QG + hn * 256 + 64 + (lane & ~1)) * 2; } } \
                if (nv) GLA_LOADS(S_, (v_) - nch, rbn, dirn, S_CTX, vrn, vvn, vqn, vkn); } } while (0)
#define GLA_STAGES(S_, par_) do { ((LAS unsigned*)RR)[gi_r * 8 + (tid & 7)] = pr_r##S_; \
            { u32x4 lo, hi4; LAS bf16_t* vt_ = VT + (par_) * (128 * GL_LD); \
              lo.x = __builtin_amdgcn_perm(pr_v##S_[1], pr_v##S_[0], 0x05040100u); lo.y = __builtin_amdgcn_perm(pr_v##S_[3], pr_v##S_[2], 0x05040100u); lo.z = __builtin_amdgcn_perm(pr_v##S_[5], pr_v##S_[4], 0x05040100u); lo.w = __builtin_amdgcn_perm(pr_v##S_[7], pr_v##S_[6], 0x05040100u); \
              hi4.x = __builtin_amdgcn_perm(pr_v##S_[1], pr_v##S_[0], 0x07060302u); hi4.y = __builtin_amdgcn_perm(pr_v##S_[3], pr_v##S_[2], 0x07060302u); hi4.z = __builtin_amdgcn_perm(pr_v##S_[5], pr_v##S_[4], 0x07060302u); hi4.w = __builtin_amdgcn_perm(pr_v##S_[7], pr_v##S_[6], 0x07060302u); \
              *(LAS u32x4*)(vt_ + (2 * lane) * GL_LD + 8 * wave) = lo; *(LAS u32x4*)(vt_ + (2 * lane + 1) * GL_LD + 8 * wave) = hi4; } \
            _Pragma("unroll") for (int tt = 0; tt < 8; ++tt) { qv[tt] = __uint_as_float((pr_q##S_[tt] >> qksh) << 16); kv[tt] = __uint_as_float((pr_k##S_[tt] >> qksh) << 16); } } while (0)
        int dirn = 0, rbn = 0, vrn = 0, vvn = 0, vqn = 0, vkn = 0, hn = 0; bool nv = false;
        if (!pre) { GLA_LOADS(0, 0, row_base, dir, T, voff_r, voff_v, voff_q, voff_k); GLA_STAGES(0, 0);
            GLA_LOADS(1, 1, row_base, dir, T, voff_r, voff_v, voff_q, voff_k); GLA_LOADS(0, 2, row_base, dir, T, voff_r, voff_v, voff_q, voff_k); }
        pre = false;
        for (int c2 = 0; c2 < nch; c2 += 2) {
#pragma unroll
          for (int par = 0; par < 2; ++par) { const int c = c2 + par;
            const int low = row_base + (dir ? (T - 64 - 64 * c) : 64 * c);
            const LAS bf16_t* VTc = VT + par * (128 * GL_LD);
            __syncthreads();
            float bl[8]; float run = 0.f;
            f32x4 zz[2];
#pragma unroll
            for (int g = 0; g < 2; ++g) { const LAS u32x4* rp = (const LAS u32x4*)((const LAS unsigned*)RR + (8 * wave + 4 * g + (lane & 3)) * 8);
                const u32x4 r0 = rp[0], r1 = rp[1];
                const s16x4 a0 = __builtin_bit_cast(s16x4, (u32x2){r0.x, r0.y}), a1 = __builtin_bit_cast(s16x4, (u32x2){r0.z, r0.w}), a2 = __builtin_bit_cast(s16x4, (u32x2){r1.x, r1.y}), a3 = __builtin_bit_cast(s16x4, (u32x2){r1.z, r1.w});
                f32x4 acc = (f32x4){bg, bg, bg, bg};
                acc = __builtin_amdgcn_mfma_f32_4x4x4bf16_1k(a0, whi[0], acc, 0, 0, 0); acc = __builtin_amdgcn_mfma_f32_4x4x4bf16_1k(a1, whi[1], acc, 0, 0, 0);
                acc = __builtin_amdgcn_mfma_f32_4x4x4bf16_1k(a2, whi[2], acc, 0, 0, 0); acc = __builtin_amdgcn_mfma_f32_4x4x4bf16_1k(a3, whi[3], acc, 0, 0, 0);
                acc = __builtin_amdgcn_mfma_f32_4x4x4bf16_1k(a0, wlo[0], acc, 0, 0, 0); acc = __builtin_amdgcn_mfma_f32_4x4x4bf16_1k(a1, wlo[1], acc, 0, 0, 0);
                acc = __builtin_amdgcn_mfma_f32_4x4x4bf16_1k(a2, wlo[2], acc, 0, 0, 0); acc = __builtin_amdgcn_mfma_f32_4x4x4bf16_1k(a3, wlo[3], acc, 0, 0, 0);
                zz[g] = acc; }
#pragma unroll
            for (int tt = 0; tt < 8; ++tt) {
                const float z = zz[tt >> 2][tt & 3];
                const float l2 = __builtin_amdgcn_logf(1.0f + __builtin_amdgcn_exp2f(-1.4426950408889634f * fabsf(z)));
                run += fminf(z, 0.f) * (1.4426950408889634f / 16.0f) - l2 * (1.0f / 16.0f); bl[tt] = run; }
            TOT[wave * 64 + lane] = run;
            __syncthreads();
            float pre = 0.f, blast = 0.f;
#pragma unroll
            for (int w2 = 0; w2 < 8; ++w2) { const float tv = TOT[w2 * 64 + lane]; blast += tv; if (w2 < wave) pre += tv; }
            float kh[8];
            const float eblast = __builtin_amdgcn_exp2f(blast);
#pragma unroll
            for (int tt = 0; tt < 8; ++tt) { const int i = 8 * wave + tt; const float eb = __builtin_amdgcn_exp2f(pre + bl[tt]), kd = kv[tt] * __builtin_amdgcn_rcpf(eb);
                QT[i * GL_LD + lane] = bf1(qv[tt] * 0.125f * eb);
                KT[i * GL_LD + lane] = bf1(kd);
                kh[tt] = kd * eblast; }
            { u32x4 w; w.x = cvt_pk_bf16(kh[0], kh[1]); w.y = cvt_pk_bf16(kh[2], kh[3]); w.z = cvt_pk_bf16(kh[4], kh[5]); w.w = cvt_pk_bf16(kh[6], kh[7]);
              *(LAS u32x4*)(KH + lane * GL_LD + 8 * wave) = w; }
            if (wave == 0) DL[lane] = eblast;
            __syncthreads();
            f32x16 oacc;
#pragma unroll
            for (int r = 0; r < 16; ++r) oacc[r] = 0.f;
#pragma unroll
            for (int ks = 0; ks < 4; ++ks) { const bf16x8 af = *(const LAS bf16x8*)(QT + (32 * oti + r32) * GL_LD + 16 * ks + 8 * hi);
                const bf16x8 bfr = *(const LAS bf16x8*)(ST + (32 * ote + r32) * GL_LD + 16 * ks + 8 * hi);
                oacc = __builtin_amdgcn_mfma_f32_32x32x16_bf16(bfr, af, oacc, 0, 0, 0); }
            if (wave < 4) { const int si = wave >> 1, sj = wave & 1;
                f32x16 p;
#pragma unroll
                for (int r = 0; r < 16; ++r) p[r] = 0.f;
                if (wave != 1) {
#pragma unroll
                    for (int ks = 0; ks < 4; ++ks) { const bf16x8 af = *(const LAS bf16x8*)(QT + (32 * si + r32) * GL_LD + 16 * ks + 8 * hi);
                        const bf16x8 bfr = *(const LAS bf16x8*)(KT + (32 * sj + r32) * GL_LD + 16 * ks + 8 * hi);
                        p = __builtin_amdgcn_mfma_f32_32x32x16_bf16(bfr, af, p, 0, 0, 0); } }
#pragma unroll
                for (int q = 0; q < 4; ++q) { const int i = 32 * si + r32, j0 = 32 * sj + 8 * q + 4 * hi; u32x2 w;
                    w.x = cvt_pk_bf16(j0 <= i ? p[4 * q] : 0.f, j0 + 1 <= i ? p[4 * q + 1] : 0.f); w.y = cvt_pk_bf16(j0 + 2 <= i ? p[4 * q + 2] : 0.f, j0 + 3 <= i ? p[4 * q + 3] : 0.f);
                    *(LAS u32x2*)(PP + i * GL_LD + j0) = w; } }
            __syncthreads();
#pragma unroll
            for (int ks = 0; ks < 4; ++ks) { const bf16x8 af = *(const LAS bf16x8*)(PP + (32 * oti + r32) * GL_LD + 16 * ks + 8 * hi);
                const bf16x8 bfr = *(const LAS bf16x8*)(VTc + (32 * ote + r32) * GL_LD + 16 * ks + 8 * hi);
                oacc = __builtin_amdgcn_mfma_f32_32x32x16_bf16(bfr, af, oacc, 0, 0, 0); }
#pragma unroll
            for (int q = 0; q < 4; ++q) { const int i = 32 * oti + r32; u32x2 w; w.x = cvt_pk_bf16(oacc[4 * q], oacc[4 * q + 1]); w.y = cvt_pk_bf16(oacc[4 * q + 2], oacc[4 * q + 3]);
                __builtin_amdgcn_raw_buffer_store_b64(w, orsrc, (dir ? 63 - i : i) * 2048 + (h * GDV + 32 * ote + 8 * q + 4 * hi) * 2, low * 2048, 0); }
#pragma unroll
            for (int q = 0; q < 4; ++q) { const f32x4 dl = *(const LAS f32x4*)(DL + 32 * std_ + 8 * q + 4 * hi);
                sacc[4 * q] *= dl[0]; sacc[4 * q + 1] *= dl[1]; sacc[4 * q + 2] *= dl[2]; sacc[4 * q + 3] *= dl[3]; }
#pragma unroll
            for (int ks = 0; ks < 4; ++ks) { const bf16x8 af = *(const LAS bf16x8*)(VTc + (32 * ste + r32) * GL_LD + 16 * ks + 8 * hi);
                const bf16x8 bfr = *(const LAS bf16x8*)(KH + (32 * std_ + r32) * GL_LD + 16 * ks + 8 * hi);
                sacc = __builtin_amdgcn_mfma_f32_32x32x16_bf16(bfr, af, sacc, 0, 0, 0); }
#pragma unroll
            for (int q = 0; q < 4; ++q) { u32x2 w; w.x = cvt_pk_bf16(sacc[4 * q], sacc[4 * q + 1]); w.y = cvt_pk_bf16(sacc[4 * q + 2], sacc[4 * q + 3]);
                *(LAS u32x2*)(ST + (32 * ste + r32) * GL_LD + 32 * std_ + 8 * q + 4 * hi) = w; }
            if (c + 1 < nch || (mode == 1 && nv)) {
                if (par == 0) GLA_STAGES(1, 1); else GLA_STAGES(0, 0);
                if (c + 1 == nch) { const float* wgp = (dirn ? a->wg_b : a->wg_f) + (size_t)l * GRANK * 512 + hn * GDK + lane;
#pragma unroll
                    for (int r = 0; r < GRANK; ++r) wgn[r] = wgp[r * 512];
                    bgn = (dirn ? a->bg_b : a->bg_f)[l * 512 + hn * GDK + lane];
                    pre = true; } }
            if (par == 0) GLA_LOADV(1, c + 3); else GLA_LOADV(0, c + 3);
            if (c == 0 && mode == 1 && tid == 0) *slot = nxt_v;
          }
        }
#undef GLA_LOADS
#undef GLA_LOADV
#undef GLA_STAGES
        if (!lat) { float* so = a->out + (dir ? OUT_SB : OUT_SF) + (((size_t)b * DEPTH + l) * GH + h) * GDK * GDV + (size_t)(32 * std_ + 4 * hi) * GDV + 32 * ste + r32;
#pragma unroll
            for (int r = 0; r < 16; ++r) so[(size_t)((r & 3) + 8 * (r >> 2)) * GDV] = sacc[r]; }
    }
}

__device__ __forceinline__ void phase_glafin(KArgsP a, int l, int G) {
    const int tid = tid_fresh(), lane = tid & 63, wave = __builtin_amdgcn_readfirstlane(tid >> 6);
    unsigned char* ws = a->ws;
    const bf16_t* OF = (const bf16_t*)(ws + WS_OF); const bf16_t* OB = (const bf16_t*)(ws + WS_OB);
    const bf16_t* PROJ = (const bf16_t*)(ws + WS_PROJ); bf16_t* MIXA = (bf16_t*)(ws + WS_MIXA);
    const int gw = blockIdx.x * 8 + wave, NGW = G * 8;
    constexpr int RB = 3;
    f32x4 gn[2]; { const float* gp = a->gla_norm + l * GDV + ((8 * lane) & 127); gn[0] = *(const f32x4*)gp; gn[1] = *(const f32x4*)(gp + 4); }
    for (int row = gw * RB; row < M; row += NGW * RB) {
        u32x4 wf[RB][2], wb[RB][2], wo[RB][2];
#pragma unroll
        for (int rr = 0; rr < RB; ++rr)
#pragma unroll
            for (int j = 0; j < 2; ++j) { const int c = 512 * j + 8 * lane; const size_t r = row + rr;
                wf[rr][j] = __builtin_nontemporal_load((const u32x4*)(OF + r * 1024 + c)); wb[rr][j] = __builtin_nontemporal_load((const u32x4*)(OB + r * 1024 + c)); wo[rr][j] = __builtin_nontemporal_load((const u32x4*)(PROJ + r * PROJ_P + C_OG + c)); }
#pragma unroll
        for (int rr = 0; rr < RB; ++rr)
#pragma unroll
            for (int j = 0; j < 2; ++j) { const u32x4 f = wf[rr][j], b = wb[rr][j], g = wo[rr][j];
                float o[8] = {bflo(f.x) + bflo(b.x), bfhi(f.x) + bfhi(b.x), bflo(f.y) + bflo(b.y), bfhi(f.y) + bfhi(b.y), bflo(f.z) + bflo(b.z), bfhi(f.z) + bfhi(b.z), bflo(f.w) + bflo(b.w), bfhi(f.w) + bfhi(b.w)};
                const float og[8] = {bflo(g.x), bfhi(g.x), bflo(g.y), bfhi(g.y), bflo(g.z), bfhi(g.z), bflo(g.w), bfhi(g.w)};
                float ss = 0.f;
#pragma unroll
                for (int e = 0; e < 8; ++e) ss += o[e] * o[e];
                ss += __shfl_xor(ss, 1); ss += __shfl_xor(ss, 2); ss += __shfl_xor(ss, 4); ss += __shfl_xor(ss, 8);
                const float rstd = 1.0f / sqrtf(ss * (1.0f / GDV) + EPS);
                float y[8];
#pragma unroll
                for (int e = 0; e < 8; ++e) y[e] = o[e] * rstd * gn[e >> 2][e & 3] * silu_f(og[e]);
                u32x4 w; w.x = cvt_pk_bf16(y[0], y[1]); w.y = cvt_pk_bf16(y[2], y[3]); w.z = cvt_pk_bf16(y[4], y[5]); w.w = cvt_pk_bf16(y[6], y[7]);
                *(u32x4*)(MIXA + (size_t)(row + rr) * DM + 1024 + 512 * j + 8 * lane) = w; }
    }
}

constexpr int PH_PER_LAYER = 9, N_PHASES = 2 + DEPTH * PH_PER_LAYER;
__global__ void __launch_bounds__(512, 2) hybrid_fwd(Args args) {
    extern __shared__ __attribute__((aligned(16))) unsigned char lds_raw[];
    LAS unsigned char* lds = (LAS unsigned char*)lds_raw;
    volatile LAS unsigned* MISC = (volatile LAS unsigned*)(lds + MISC_OFF);
    const int tid = threadIdx.x, G = gridDim.x;
    KArgsP ka0 = ka_get();
    unsigned char* ws = ka0->ws;
    gu32* ctl = (gu32*)(ws + WS_CTL);
    for (int u = tid; u < (LDS_BYTES - RING_BYTES) / 4; u += 512) ((LAS unsigned*)(lds + RING_BYTES))[u] = 0u;
    __syncthreads();
#if MK_PER_PHASE
#define GRID_BAR() do { } while (0)
#else
    XcdBarrier bar = xcd_barrier_post((unsigned*)(ctl + CW_BAR), MISC + 8);
#define GRID_BAR() xcd_barrier(bar)
#endif
    const int lo = ka0->ph_lo, hi = ka0->ph_hi;
#define IN(k) (lo <= (k) && (k) < hi)
#ifndef MK_DUPBAR
#define MK_DUPBAR 0
#endif
#define SEAM(k) do { if (IN(k) && IN((k) + 1)) { GRID_BAR(); if (MK_DUPBAR) GRID_BAR(); } } while (0)
    bf16_t* XB = (bf16_t*)(ws + WS_XB);
    const float* MOD = (const float*)(ws + WS_MOD);
    bf16_t* H = (bf16_t*)(ws + WS_H); bf16_t* PROJ = (bf16_t*)(ws + WS_PROJ); bf16_t* MIXA = (bf16_t*)(ws + WS_MIXA); bf16_t* HID = (bf16_t*)(ws + WS_HID);

    if (HAS(0) && IN(0)) { for (int rep = 0; rep < DUP(0); ++rep) { if (MK_DUPSYNC && rep) GRID_BAR(); phase_prologue(ka_get(), lds, G); __syncthreads(); } } SEAM(0);

    for (int l = 0; l < DEPTH; ++l) {
        const int p0 = 1 + l * PH_PER_LAYER;
        const float* mod_l = MOD + (size_t)l * NGRP * (6 * DM);

        if (HAS(1) && IN(p0 + 0)) for (int rep = 0; rep < DUP(1); ++rep) { if (MK_DUPSYNC && rep) GRID_BAR();
            phase_norm(XB, (l == 0 || rep) ? nullptr : (const bf16_t*)(ws + WS_SIDE), ka_get()->norm1 + l * DM, mod_l, 0 * DM, 1 * DM, H, G, l == 0 && rep == 0); } SEAM(p0 + 0);
        for (int sub = 0; sub < 2; ++sub) {
            if (HAS(2) && IN(p0 + 1 + sub)) for (int rep = 0; rep < DUP(10 + sub); ++rep) { if (MK_DUPSYNC && rep) GRID_BAR(); constexpr int NU = (M / 256) * (PROJ_P / 256), NA3 = 3 * 256;
                pg8::Gemm g{H, (const bf16_t*)(ws + WS_WIN) + (size_t)l * PROJ_P * DM, M, PROJ_P, DM}; pg8::InOrder S; S.init(G, (int)blockIdx.x, sub ? NA3 : 0, sub ? NU : NA3);
                KArgsP ka = ka_get(); pg8::EpiIn E{PROJ, ws, ka->out, ka->k_norm + l * HD, (LAS float*)(lds + RING_BYTES + 2048), l}; pg8::gemm_phase<pg8::EpiIn, pg8::InOrder, true, true>(lds, g, S, E);
                if (sub == 1 && HAS(4) && NA3 + (int)blockIdx.x >= NU) { __syncthreads(); phase_attn(ka_get(), l, (char*)lds_raw, ctl + CW_Q + 64 * (3 * l), MISC + 16, 0, 1); __syncthreads(); } }
            SEAM(p0 + 1 + sub); }


        if (IN(p0 + 3)) for (int rep = 0; rep < ((DUP(4) == 2 || DUP(5) == 2) ? 2 : 1); ++rep) { if (MK_DUPSYNC && rep) GRID_BAR();
            for (int pass = 0; pass < 2; ++pass) {
                if (HAS(5)) { phase_gla(ka_get(), l, lds, ctl + CW_Q + 64 * (3 * l + 1 + 16 * rep), MISC + 17, pass, G); __syncthreads(); }
                if (MK_PROBE_GLALAT && pass == 0) { GRID_BAR(); phase_gla(ka_get(), l, lds, ctl + CW_Q + 64 * (3 * l + 1 + 16 * rep), MISC + 17, 0, G); __syncthreads(); GRID_BAR(); }
                if (HAS(4) && pass == 0) { phase_attn(ka_get(), l, (char*)lds_raw, ctl + CW_Q + 64 * (3 * l + 16 * rep), MISC + 16, 0, 1 << 30); __syncthreads(); } } } SEAM(p0 + 3);
        if (IN(p0 + 4)) for (int rep = 0; rep < DUP(6); ++rep) { if (MK_DUPSYNC && rep) GRID_BAR();
            const bool attn_first = (blockIdx.x >> 3) & 1;
            if (HAS(4) && attn_first) { phase_attn(ka_get(), l, (char*)lds_raw, ctl + CW_Q + 64 * (3 * l + 2 + 16 * rep), MISC + 16, 1, 1 << 30); __syncthreads(); }
            if (HAS(6)) phase_glafin(ka_get(), l, G);
            if (HAS(4) && !attn_first) { __syncthreads(); phase_attn(ka_get(), l, (char*)lds_raw, ctl + CW_Q + 64 * (3 * l + 2 + 16 * rep), MISC + 16, 1, 1 << 30); __syncthreads(); } } SEAM(p0 + 4);
        if (HAS(7) && IN(p0 + 5)) for (int rep = 0; rep < DUP(7); ++rep) { if (MK_DUPSYNC && rep) GRID_BAR(); pg8::Gemm g{MIXA, (const bf16_t*)(ws + WS_WOUT) + (size_t)l * DM * DM, M, DM, DM}; pg8::SplitLatOrder S; S.init(DM, G, (int)blockIdx.x, WG_SPL);
            pg8::EpiResid E{XB, mod_l + 2 * DM, (bf16_t*)(ws + WS_SIDE), (DUP(7) == 2 && rep == 0) ? (lo >= 0) : 0}; pg8::gemm_phase<pg8::EpiResid, pg8::SplitLatOrder, true, true>(lds, g, S, E); } SEAM(p0 + 5);
        if (HAS(1) && IN(p0 + 6)) for (int rep = 0; rep < DUP(1); ++rep) { if (MK_DUPSYNC && rep) GRID_BAR(); phase_norm(XB, rep ? nullptr : (const bf16_t*)(ws + WS_SIDE), ka_get()->norm2 + l * DM, mod_l, 3 * DM, 4 * DM, H, G); } SEAM(p0 + 6);
        if (HAS(8) && IN(p0 + 7)) for (int rep = 0; rep < DUP(8); ++rep) { if (MK_DUPSYNC && rep) GRID_BAR(); pg8::Gemm g{H, (const bf16_t*)(ws + WS_WUP) + (size_t)l * DFF * DM, M, DFF, DM}; pg8::StaticOrder S; S.init(M, DFF, G, (int)blockIdx.x, DM, WG_UP);
            pg8::EpiBf16<1> E{HID, DFF}; pg8::gemm_phase<pg8::EpiBf16<1>, pg8::StaticOrder, true, true>(lds, g, S, E); } SEAM(p0 + 7);
        if (HAS(9) && IN(p0 + 8)) for (int rep = 0; rep < DUP(9); ++rep) { if (MK_DUPSYNC && rep) GRID_BAR(); pg8::Gemm g{HID, (const bf16_t*)(ws + WS_WDN) + (size_t)l * DM * DFF, M, DM, DFF}; pg8::SplitLatOrder S; S.init(DFF, G, (int)blockIdx.x, WG_SPL);
            pg8::EpiResid E{XB, mod_l + 5 * DM, (bf16_t*)(ws + WS_SIDE), (DUP(9) == 2 && rep == 0) ? (lo >= 0) : ((l == DEPTH - 1) ? 2 : 0)}; pg8::gemm_phase<pg8::EpiResid, pg8::SplitLatOrder, true, true>(lds, g, S, E); } SEAM(p0 + 8);
    }
    if (IN(N_PHASES - 1)) { const int t2 = tid_fresh(); float* Y = ka_get()->out + OUT_Y; const bf16_t* sd = (const bf16_t*)(ws + WS_SIDE);
        for (size_t i = (size_t)M_CTX * DM / 8 + (size_t)blockIdx.x * 512 + t2; i < (size_t)M * DM / 8; i += (size_t)G * 512) { const u32x4 w = __builtin_nontemporal_load((const u32x4*)(XB + i * 8));
            f32x4 a = (f32x4){bflo(w.x), bfhi(w.x), bflo(w.y), bfhi(w.y)}, b = (f32x4){bflo(w.z), bfhi(w.z), bflo(w.w), bfhi(w.w)};
            if (i >= (size_t)M_CTX * DM / 8) { const u32x4 v = __builtin_nontemporal_load((const u32x4*)(sd + (i - (size_t)M_CTX * DM / 8) * 8));
                a += (f32x4){bflo(v.x), bfhi(v.x), bflo(v.y), bfhi(v.y)}; b += (f32x4){bflo(v.z), bfhi(v.z), bflo(v.w), bfhi(v.w)}; }
            __builtin_nontemporal_store(a, (f32x4*)(Y + i * 8)); __builtin_nontemporal_store(b, (f32x4*)(Y + i * 8 + 4)); } }
#undef IN
#undef SEAM
}

extern "C" void kernel_launch(void* const* d_in, const int* in_sizes, int n_in, void* d_out, int out_size, void* d_ws, size_t ws_size, hipStream_t stream) {
    static int grid = 0;
    if (grid == 0) {
        if (n_in != 23 || (size_t)out_size != OUT_END || ws_size < WS_END) { fprintf(stderr, "kernel_launch: unexpected shapes (n_in %d out %d ws %zu)\n", n_in, out_size, ws_size); grid = -1; return; }
        int dev = 0, cus = 0, per_cu = 0;
        if (hipGetDevice(&dev) != hipSuccess || hipDeviceGetAttribute(&cus, hipDeviceAttributeMultiprocessorCount, dev) != hipSuccess) { grid = -1; return; }
        if (hipFuncSetAttribute((const void*)hybrid_fwd, hipFuncAttributeMaxDynamicSharedMemorySize, LDS_BYTES) != hipSuccess) { fprintf(stderr, "kernel_launch: hipFuncSetAttribute failed\n"); grid = -1; return; }
        if (hipOccupancyMaxActiveBlocksPerMultiprocessor(&per_cu, (const void*)hybrid_fwd, 512, LDS_BYTES) != hipSuccess || per_cu < 1) { fprintf(stderr, "kernel_launch: occupancy query says %d\n", per_cu); }
        (void)hipGetLastError();
        grid = cus;
    }
    if (grid < 0) return;
    if (hipMemsetAsync((char*)d_ws + WS_CTL, 0, CTL_ZERO_BYTES, stream) != hipSuccess) return;
    Args a{};
    a.x_prompt = (const float*)d_in[0]; a.x_sample = (const float*)d_in[1]; a.cache_k = (const float*)d_in[2]; a.cache_v = (const float*)d_in[3];
    a.st_f = (const float*)d_in[4]; a.st_b = (const float*)d_in[5]; a.c = (const float*)d_in[6]; a.c_ctx = (const float*)d_in[7];
    a.w_mod = (const float*)d_in[8]; a.b_mod = (const float*)d_in[9]; a.norm1 = (const float*)d_in[10]; a.w_in = (const float*)d_in[11];
    a.q_norm = (const float*)d_in[12]; a.k_norm = (const float*)d_in[13]; a.wg_f = (const float*)d_in[14]; a.bg_f = (const float*)d_in[15];
    a.wg_b = (const float*)d_in[16]; a.bg_b = (const float*)d_in[17]; a.gla_norm = (const float*)d_in[18]; a.w_out = (const float*)d_in[19];
    a.norm2 = (const float*)d_in[20]; a.w_up = (const float*)d_in[21]; a.w_down = (const float*)d_in[22];
    a.out = (float*)d_out; a.ws = (unsigned char*)d_ws;
#if MK_PER_PHASE
    for (int p = 0; p < N_PHASES; ++p) { a.ph_lo = p; a.ph_hi = p + 1; hipLaunchKernelGGL(hybrid_fwd, dim3(grid), dim3(512), LDS_BYTES, stream, a); }
#else
    a.ph_lo = 0; a.ph_hi = N_PHASES;
    hipLaunchKernelGGL(hybrid_fwd, dim3(grid), dim3(512), LDS_BYTES, stream, a);
#endif
    const hipError_t le = hipPeekAtLastError();
    if (le != hipSuccess) fprintf(stderr, "kernel_launch: launch failed: %s\n", hipGetErrorName(le));
}
```

```cpp
#include <hip/hip_runtime.h>
#include <cstdio>
#include <cstdint>

#ifndef MK_PER_PHASE
#define MK_PER_PHASE 0
#endif
#ifndef CONV_TAILS
#define CONV_TAILS 0
#endif
#ifndef WG_IN
#define WG_IN 4
#endif
#ifndef WG_UP
#define WG_UP 8
#endif
#ifndef WG_SPL
#define WG_SPL 4
#endif
#ifndef PRO_NT
#define PRO_NT 1
#endif
#ifndef MK_MASK
#define MK_MASK 0x3ff
#endif
#define HAS(k) ((MK_MASK >> (k)) & 1)
#ifndef MK_DUP
#define MK_DUP 0
#endif
#define DUP(k) (((MK_DUP >> (k)) & 1) ? 2 : 1)
#ifndef MK_PROBE_GLALAT
#define MK_PROBE_GLALAT 0
#endif
#ifndef MK_DUPSYNC
#define MK_DUPSYNC 0
#endif

#define LAS __attribute__((address_space(3)))
#define GAS __attribute__((address_space(1)))
typedef unsigned short bf16_t;
typedef short bf16x8 __attribute__((ext_vector_type(8)));
typedef short s16x4 __attribute__((ext_vector_type(4)));
typedef float f32x2 __attribute__((ext_vector_type(2)));
typedef float f32x4 __attribute__((ext_vector_type(4)));
typedef float f32x16 __attribute__((ext_vector_type(16)));
typedef unsigned u32x2 __attribute__((ext_vector_type(2)));
typedef unsigned u32x4 __attribute__((ext_vector_type(4)));
typedef GAS unsigned gu32;

constexpr int DM = 2048, NB_CTX = 32, S_CTX = 256, DEPTH = 4, NB_LAT = 4, S_LAT = 1024, PAST = 256;
constexpr int M_CTX = NB_CTX * S_CTX, M_LAT = NB_LAT * S_LAT, M = M_CTX + M_LAT;
constexpr int HD = 128, NQH = 8, NKVH = 2, KVW = 256, GH = 8, GDK = 64, GDV = 128, GRANK = 16;
constexpr int DFF = 8192, PROJ_W = 4640, PROJ_P = 4864;
constexpr int C_Q = 0, C_K = 1024, C_V = 1280, C_QG = 1536, C_KG = 2048, C_VG = 2560, C_OG = 3584, C_RF = 4608, C_RB = 4624;
constexpr int NGRP = 1 + NB_LAT;
constexpr int S_KVL = PAST + S_LAT;
constexpr float EPS = 1e-6f;

constexpr size_t MiB = 1u << 20;
constexpr size_t WS_CTL = 0, CTL_ZERO_BYTES = 128 * 1024;
constexpr size_t WS_MOD = 1 * MiB;
constexpr size_t WS_ROPE = 2 * MiB;
constexpr size_t WS_WIN = 4 * MiB;
constexpr size_t WS_WOUT = 80 * MiB;
constexpr size_t WS_WUP = 112 * MiB;
constexpr size_t WS_WDN = 240 * MiB;
constexpr size_t WS_H = 368 * MiB;
constexpr size_t WS_PROJ = 416 * MiB;
constexpr size_t WS_MIXA = 530 * MiB;
constexpr size_t WS_HID = 578 * MiB;
constexpr size_t WS_KC = 770 * MiB, WS_VC = 774 * MiB;
constexpr size_t WS_KL = 778 * MiB, WS_VL = 788 * MiB;
constexpr size_t WS_OF = 798 * MiB, WS_OB = 846 * MiB;
constexpr size_t WS_SIDE = 894 * MiB;
constexpr size_t WS_XB = 912 * MiB;
constexpr size_t WS_END = 960 * MiB;
static_assert(WS_WIN + (size_t)DEPTH * PROJ_P * DM * 2 <= WS_WOUT && WS_PROJ + (size_t)M * PROJ_P * 2 <= WS_MIXA && WS_HID + (size_t)M * DFF * 2 <= WS_KC, "ws map");
static_assert(WS_KL + (size_t)DEPTH * NB_LAT * S_KVL * KVW * 2 <= WS_VL && WS_OF + (size_t)M * 1024 * 4 <= WS_OB, "ws map 2");
constexpr int CW_BAR = 4096;
constexpr int CW_Q = 16384;
constexpr size_t OUT_Y = 0, OUT_CK = (size_t)M * DM, OUT_CV = OUT_CK + (size_t)M_CTX * DEPTH * KVW, OUT_SF = OUT_CV + (size_t)M_CTX * DEPTH * KVW,
                 OUT_SB = OUT_SF + (size_t)NB_CTX * DEPTH * GH * GDK * GDV, OUT_END = OUT_SB + (size_t)NB_CTX * DEPTH * GH * GDK * GDV;

constexpr int RING_BYTES = 131072, MISC_OFF = RING_BYTES + 320, LDS_BYTES = 147456;

typedef __bf16 bf16x2_t __attribute__((ext_vector_type(2)));
typedef short s16x4 __attribute__((ext_vector_type(4)));
__device__ __forceinline__ unsigned cvt_pk_bf16(float lo, float hi) { const f32x2 v = {lo, hi}; const bf16x2_t b = __builtin_convertvector(v, bf16x2_t); return __builtin_bit_cast(unsigned, b); }
__device__ __forceinline__ unsigned f2bf(float f) { unsigned u = __builtin_bit_cast(unsigned, f); return (u + 0x7fffu + ((u >> 16) & 1u)) >> 16; }
__device__ __forceinline__ unsigned pk2(float lo, float hi) { return f2bf(lo) | (f2bf(hi) << 16); }
__device__ __forceinline__ float bf2f(unsigned short b) { return __builtin_bit_cast(float, ((unsigned)b) << 16); }
__device__ __forceinline__ float bflo(unsigned w) { return __builtin_bit_cast(float, w << 16); }
__device__ __forceinline__ float bfhi(unsigned w) { return __builtin_bit_cast(float, w & 0xffff0000u); }
__device__ __forceinline__ int tid_fresh() { int t = threadIdx.x; asm volatile("" : "+v"(t)); return t; }
#define LDS_WAIT() asm volatile("s_waitcnt lgkmcnt(0)" ::: "memory")
#define VM_WAIT() asm volatile("s_waitcnt vmcnt(0)" ::: "memory")

__device__ __forceinline__ float* mk_out_ptr();
namespace pg8 {
constexpr int BM = 256, BK = 64, HALF = 128, HTB = HALF * BK * 2, STAGE_BYTES = 8 * HTB, NXCD = 8;
__host__ __device__ __forceinline__ int lds_byte(int r, int c) { const int st = (r >> 4) * 2 + (c >> 5), rr = r & 15, cc = c & 31, ob = rr * 64 + cc * 2; return st * 1024 + (ob ^ (((ob >> 9) & 1) << 5)); }
__host__ __device__ __forceinline__ void stage_rc(int b, int& R, int& C) { const int st = b / 1024, sb = b % 1024, swz = sb ^ (((sb >> 9) & 1) << 5); R = (st >> 1) * 16 + swz / 64; C = (st & 1) * 32 + (swz % 64) / 2; }
__host__ __device__ __forceinline__ int perm32(int rho) { const int n = rho >> 4, i = rho & 15; return 8 * (i >> 2) + 4 * n + (i & 3); }

struct Unit { int pm, pn, k0, nt, aux; };
struct Gemm { const bf16_t* A; const bf16_t* Bt; int M, N, K; };

struct StaticOrder {
    int nM, nN, nwg, G, c, ntf, WGM;
    __device__ void init(int M_, int N_, int G_, int c_, int K_, int wgm = 4) { nM = M_ / BM; nN = N_ / BM; nwg = nM * nN; G = G_; c = c_; ntf = K_ / BK; WGM = wgm; }
    __device__ void map(int wgid, Unit& u) const {
        { const int q = nwg / NXCD, r = nwg % NXCD, xcd = wgid % NXCD, off = wgid / NXCD; wgid = (xcd < r ? xcd * (q + 1) : r * (q + 1) + (xcd - r) * q) + off; }
        const int nig = WGM * nN, gid = wgid / nig, fm = gid * WGM, gsz = (nM - fm) < WGM ? (nM - fm) : WGM;
        u.pm = fm + ((wgid % nig) % gsz); u.pn = (wgid % nig) / gsz; u.k0 = 0; u.nt = ntf; u.aux = 0;
    }
    __device__ bool next(int i, Unit& u) const { const long L = (long)i * G + c; if (L >= nwg) return false; map((int)L, u); return true; }
    __device__ __forceinline__ void a_ready(const Unit&) const {}
    __device__ __forceinline__ void done(const Unit&) const {}
};
struct InOrder {
    int G, c, base, limit;
    __device__ void init(int G_, int c_, int base_, int limit_) { G = G_; c = c_; base = base_; limit = limit_; }
    __device__ bool next(int i, Unit& u) const {
        const long L = (long)base + (long)i * G + c; if (L >= limit) return false;
        const int xcd = (int)(L % NXCD), off = (int)(L / NXCD);
        if (off >= 58 && off < 96) { const int j = 38 * xcd + (off - 58), gid = j / 76, w = j % 76; u.pm = M_CTX / BM + 4 * gid + (w & 3); u.pn = w >> 2; }
        else { const int w = off < 58 ? off : off - 38; u.pm = 4 * xcd + (w & 3); u.pn = w >> 2; }
        u.k0 = 0; u.nt = DM / BK; u.aux = 0; return true;
    }
    __device__ __forceinline__ void a_ready(const Unit&) const {}
    __device__ __forceinline__ void done(const Unit&) const {}
};
static_assert((M_LAT / BM) * (PROJ_P / BM) == 8 * 38 && (M_CTX / BM) * (PROJ_P / BM) == 8 * 76, "InOrder: 38 latent + 76 context units per XCD slot");
struct SplitLatOrder {
    StaticOrder sa, sb; int G, c, nth;
    __device__ void init(int K_, int G_, int c_, int wgm = 4) { G = G_; c = c_; nth = K_ / BK / 2; sa.init(M_CTX, DM, G_, c_, K_, wgm); sb.init(M_LAT, 2 * DM, G_, c_, K_, wgm); }
    __device__ bool next(int i, Unit& u) const {
        long L = (long)i * G + c;
        if (G == sa.nwg && G == sb.nwg && (c & 4) && i < 2) L = (long)(1 - i) * G + c;
        if (L < sa.nwg) { sa.map((int)L, u); return true; }
        if (L < sa.nwg + sb.nwg) { sb.map((int)(L - sa.nwg), u); const int kh = u.pn >> 3; u.pn &= 7; u.pm += M_CTX / BM; u.k0 = kh * nth * BK; u.nt = nth; u.aux = kh; return true; }
        return false;
    }
    __device__ __forceinline__ void a_ready(const Unit&) const {}
    __device__ __forceinline__ void done(const Unit&) const {}
};

template <int ACT  > struct EpiBf16 {
    static constexpr bool PERM = true, AFTER_DRAIN = false;
    bf16_t* O; int ldc;
    __device__ __forceinline__ void operator()(const f32x4 (&acc)[2][2][4][2], const Unit& u, int wr, int wc, int fr, int fq) const {
        const int row0 = u.pm * BM + wr * 64 + fr, col0 = u.pn * BM + wc * 32 + 8 * fq;
#pragma unroll
        for (int ai = 0; ai < 2; ++ai)
#pragma unroll
            for (int m = 0; m < 4; ++m) { bf16_t* rowp = O + (size_t)(row0 + ai * HALF + m * 16) * ldc + col0;
#pragma unroll
                for (int bj = 0; bj < 2; ++bj) { f32x4 v0 = acc[ai][bj][m][0], v1 = acc[ai][bj][m][1];
                    if (ACT == 1) {
#pragma unroll
                        for (int j = 0; j < 4; ++j) { const float a = fmaxf(v0[j], 0.f), b = fmaxf(v1[j], 0.f); v0[j] = a * a; v1[j] = b * b; } }
                    u32x4 w; w.x = cvt_pk_bf16(v0[0], v0[1]); w.y = cvt_pk_bf16(v0[2], v0[3]); w.z = cvt_pk_bf16(v1[0], v1[1]); w.w = cvt_pk_bf16(v1[2], v1[3]);
                    *(u32x4*)(rowp + bj * HALF) = w; } }
    }
};
struct EpiIn {
    static constexpr bool PERM = true, AFTER_DRAIN = false;
    bf16_t* O; unsigned char* ws; float* out; const float* kn; LAS float* xl; int l;
    __device__ __forceinline__ void operator()(const f32x4 (&acc)[2][2][4][2], const Unit& u, int wr, int wc, int fr, int fq_) const {
        int fq = fq_;
        int rl0 = wr * 64 + fr;
        asm volatile("" : "+v"(rl0), "+v"(fq));
        const bool lat = u.pm >= M_CTX / BM;
        const int b = lat ? (u.pm - M_CTX / BM) >> 2 : u.pm, t0 = lat ? ((u.pm - M_CTX / BM) & 3) * 256 : 0;
        bf16_t* kvdst = (bf16_t*)(ws + (u.pn == 4 ? (lat ? WS_KL : WS_KC) : (lat ? WS_VL : WS_VC))) + (lat ? ((size_t)(l * NB_LAT + b) * S_KVL + PAST + t0) * KVW : (size_t)u.pm * BM * KVW);
        float* cout = out + (u.pn == 4 ? OUT_CK : OUT_CV) + ((size_t)b * DEPTH + l) * S_CTX * KVW;
        if (u.pn != 4 && u.pn != 5) {
            const bool isv = false;
            bf16_t* dst = isv ? kvdst + wc * 32 + 8 * fq : O + (size_t)u.pm * BM * PROJ_P + u.pn * BM + wc * 32 + 8 * fq;
            const int ld = isv ? KVW : PROJ_P;
            float* co = cout + wc * 32 + 8 * fq;
#pragma unroll
            for (int ai = 0; ai < 2; ++ai)
#pragma unroll
                for (int m = 0; m < 4; ++m) { const int rl = rl0 + ai * HALF + m * 16;
#pragma unroll
                    for (int bj = 0; bj < 2; ++bj) { const f32x4 v0 = acc[ai][bj][m][0], v1 = acc[ai][bj][m][1];
                        u32x4 w; w.x = cvt_pk_bf16(v0[0], v0[1]); w.y = cvt_pk_bf16(v0[2], v0[3]); w.z = cvt_pk_bf16(v1[0], v1[1]); w.w = cvt_pk_bf16(v1[2], v1[3]);
                        *(u32x4*)(dst + rl * ld + bj * HALF) = w;
                        if (isv && !lat) { *(f32x4*)(co + rl * KVW + bj * HALF) = v0; *(f32x4*)(co + rl * KVW + bj * HALF + 4) = v1; } }
                    asm volatile("" ::: "memory"); }
            return;
        }
        const bool isk = u.pn == 4;
        const int g = 4 * wc + fq, base = g < 8 ? 4 * g : 64 + 4 * (g - 8);
        const float* RP = (const float*)(ws + WS_ROPE);
        const int rpo = (g >> 3) * 64 + 4 * (g & 7);
        f32x4 rcv[2][4], rsv[2][4];
#pragma unroll
        for (int ai = 0; ai < 2; ++ai)
#pragma unroll
            for (int m = 0; m < 4; ++m) { rcv[ai][m] = (f32x4){1.f, 1.f, 1.f, 1.f}; rsv[ai][m] = (f32x4){0.f, 0.f, 0.f, 0.f};
                if (lat && isk) { const float* rp = RP + (size_t)(t0 + rl0 + ai * HALF + m * 16) * 128 + rpo; rcv[ai][m] = *(const f32x4*)rp; rsv[ai][m] = *(const f32x4*)(rp + 32); } }
        const f32x4 one4 = (f32x4){1.f, 1.f, 1.f, 1.f};
        const f32x4 gk0 = isk ? *(const f32x4*)(kn + base) : one4, gk1 = isk ? *(const f32x4*)(kn + base + 32) : one4;
        if (isk) {
#pragma unroll
        for (int ai = 0; ai < 2; ++ai)
#pragma unroll
            for (int m = 0; m < 4; ++m)
#pragma unroll
                for (int bj = 0; bj < 2; ++bj) { const f32x4 v0 = acc[ai][bj][m][0], v1 = acc[ai][bj][m][1];
                    float ss = (v0[0] * v0[0] + v0[1] * v0[1]) + (v0[2] * v0[2] + v0[3] * v0[3]) + (v1[0] * v1[0] + v1[1] * v1[1]) + (v1[2] * v1[2] + v1[3] * v1[3]);
                    ss += __shfl_xor(ss, 16); ss += __shfl_xor(ss, 32);
                    if (fq == 0) xl[((rl0 + ai * HALF + m * 16) * 2 + bj) * 4 + wc] = ss; }
        asm volatile("s_waitcnt lgkmcnt(0)" ::: "memory"); __builtin_amdgcn_s_barrier(); asm volatile("" ::: "memory"); }
#pragma unroll
        for (int ai = 0; ai < 2; ++ai)
#pragma unroll
            for (int m = 0; m < 4; ++m) { const int rl = rl0 + ai * HALF + m * 16; const f32x4 rc = rcv[ai][m], rs = rsv[ai][m];
#pragma unroll
                for (int bj = 0; bj < 2; ++bj) { float rstd = 1.0f;
                    if (isk) { const f32x4 pp = *(const LAS f32x4*)(xl + (rl * 2 + bj) * 4); rstd = __builtin_amdgcn_rsqf(((pp[0] + pp[1]) + (pp[2] + pp[3])) * (1.0f / HD) + EPS); }
                    const f32x4 y0 = acc[ai][bj][m][0] * rstd * gk0, y1 = acc[ai][bj][m][1] * rstd * gk1;
                    if (!lat) { *(f32x4*)(cout + (size_t)rl * KVW + bj * HALF + base) = y0; *(f32x4*)(cout + (size_t)rl * KVW + bj * HALF + base + 32) = y1; }
                    const f32x4 z0 = y0 * rc - y1 * rs, z1 = y1 * rc + y0 * rs;
                    u32x2 w0, w1; w0.x = cvt_pk_bf16(z0[0], z0[1]); w0.y = cvt_pk_bf16(z0[2], z0[3]); w1.x = cvt_pk_bf16(z1[0], z1[1]); w1.y = cvt_pk_bf16(z1[2], z1[3]);
                    *(u32x2*)(kvdst + (size_t)rl * KVW + bj * HALF + base) = w0; *(u32x2*)(kvdst + (size_t)rl * KVW + bj * HALF + base + 32) = w1; } }
    }
};
struct EpiResid {
    static constexpr bool PERM = true, AFTER_DRAIN = false;
    bf16_t* xb; const float* gate; bf16_t* side; int dry;
    __device__ __forceinline__ void operator()(const f32x4 (&acc)[2][2][4][2], const Unit& u, int wr, int wc, int fr, int fq) const {
        if (dry == 1) return;
        const int row0 = u.pm * BM + wr * 64 + fr, col0 = u.pn * BM + wc * 32 + 8 * fq;
        const int grp = u.pm < (M_CTX / BM) ? 0 : 1 + ((u.pm - M_CTX / BM) >> 2);
        const float* gp = gate + (size_t)grp * (6 * DM) + col0;
        f32x4 gv[2][2];
#pragma unroll
        for (int bj = 0; bj < 2; ++bj)
#pragma unroll
            for (int n = 0; n < 2; ++n) gv[bj][n] = *(const f32x4*)(gp + bj * HALF + 4 * n);
        if (u.aux) {
            bf16_t* sp = side + (size_t)(row0 - M_CTX) * DM + col0;
#pragma unroll
            for (int ai = 0; ai < 2; ++ai)
#pragma unroll
                for (int m = 0; m < 4; ++m)
#pragma unroll
                    for (int bj = 0; bj < 2; ++bj) { const f32x4 v0 = gv[bj][0] * acc[ai][bj][m][0], v1 = gv[bj][1] * acc[ai][bj][m][1];
                        u32x4 w; w.x = cvt_pk_bf16(v0[0], v0[1]); w.y = cvt_pk_bf16(v0[2], v0[3]); w.z = cvt_pk_bf16(v1[0], v1[1]); w.w = cvt_pk_bf16(v1[2], v1[3]);
                        *(u32x4*)(sp + (size_t)(ai * HALF + m * 16) * DM + bj * HALF) = w; }
            return;
        }
        bf16_t* xp = xb + (size_t)row0 * DM + col0;
        u32x4 bq[2][4][2];
#pragma unroll
        for (int ai = 0; ai < 2; ++ai)
#pragma unroll
            for (int m = 0; m < 4; ++m)
#pragma unroll
                for (int bj = 0; bj < 2; ++bj) bq[ai][m][bj] = *(const u32x4*)(xp + (size_t)(ai * HALF + m * 16) * DM + bj * HALF);
#pragma unroll
        for (int ai = 0; ai < 2; ++ai)
#pragma unroll
            for (int m = 0; m < 4; ++m)
#pragma unroll
                for (int bj = 0; bj < 2; ++bj) { const u32x4 b = bq[ai][m][bj]; const f32x4 a0 = gv[bj][0] * acc[ai][bj][m][0], a1 = gv[bj][1] * acc[ai][bj][m][1];
                    if (dry == 2 && u.pm < M_CTX / BM) { float* yp = mk_out_ptr() + OUT_Y + (size_t)(row0 + ai * HALF + m * 16) * DM + col0 + bj * HALF;
                        __builtin_nontemporal_store((f32x4){bflo(b.x) + a0[0], bfhi(b.x) + a0[1], bflo(b.y) + a0[2], bfhi(b.y) + a0[3]}, (f32x4*)yp);
                        __builtin_nontemporal_store((f32x4){bflo(b.z) + a1[0], bfhi(b.z) + a1[1], bflo(b.w) + a1[2], bfhi(b.w) + a1[3]}, (f32x4*)(yp + 4)); continue; }
                    u32x4 w; w.x = cvt_pk_bf16(bflo(b.x) + a0[0], bfhi(b.x) + a0[1]); w.y = cvt_pk_bf16(bflo(b.y) + a0[2], bfhi(b.y) + a0[3]);
                    w.z = cvt_pk_bf16(bflo(b.z) + a1[0], bfhi(b.z) + a1[1]); w.w = cvt_pk_bf16(bflo(b.w) + a1[2], bfhi(b.w) + a1[3]);
                    *(u32x4*)(xp + (size_t)(ai * HALF + m * 16) * DM + bj * HALF) = w; }
    }
};

template <class Epi, class Sched, bool ALIGN_EPI = false, bool SP2 = false>
__device__ __forceinline__ void gemm_phase(LAS unsigned char* lds, const Gemm g, const Sched& S, const Epi& E) {
    const int tid = tid_fresh(), wid = __builtin_amdgcn_readfirstlane(tid >> 6), lane = tid & 63, wr = wid >> 2, wc = wid & 3, fr = lane & 15, fq = lane >> 4;
    const int K = g.K;
    unsigned voffA[2], voffB[2];
#pragma unroll
    for (int i = 0; i < 2; ++i) { int R, C; stage_rc(tid * 16 + i * 8192, R, C); const int Rb = Epi::PERM ? ((R & ~31) + perm32(R & 31)) : R;
        voffA[i] = (unsigned)(R * K + C) * 2u; voffB[i] = (unsigned)(Rb * K + C) * 2u; }
    const size_t kstep = (size_t)(BK * 2);
    const size_t hstep = (size_t)HALF * K * 2;
    const size_t tstep = 2 * hstep;
    const unsigned ldsw = (unsigned)wid * 1024u;
    const int aoff = lds_byte(wr * 64 + fr, fq * 8), boff = lds_byte(wc * 32 + fr, fq * 8);
#define PG8_SA(b, h) (((b) * 2 + (h)) * HTB)
#define PG8_SB(b, h) ((4 + (b) * 2 + (h)) * HTB)
#define PG8_STAGE(bufoff, gbase, voff) do { _Pragma("unroll") for (int _i = 0; _i < 2; ++_i) \
        __builtin_amdgcn_global_load_lds((const unsigned*)((const char*)(gbase) + (voff)[_i]), (LAS unsigned*)(lds + (bufoff) + ldsw + _i * 8192), 16, 0, 0); } while (0)
#define PG8_LDA(dst, b, h) do { _Pragma("unroll") for (int m = 0; m < 4; ++m) _Pragma("unroll") for (int k = 0; k < 2; ++k) dst[m][k] = *(const LAS bf16x8*)(lds + PG8_SA(b, h) + aoff + m * 2048 + k * 1024); } while (0)
#define PG8_LDB(dst, b, h) do { _Pragma("unroll") for (int n = 0; n < 2; ++n) _Pragma("unroll") for (int k = 0; k < 2; ++k) dst[n][k] = *(const LAS bf16x8*)(lds + PG8_SB(b, h) + boff + n * 2048 + k * 1024); } while (0)
#define PG8_MMA(ai, bj, At, Bt) do { __builtin_amdgcn_s_setprio(1); _Pragma("unroll") for (int m = 0; m < 4; ++m) _Pragma("unroll") for (int n = 0; n < 2; ++n) _Pragma("unroll") for (int k = 0; k < 2; ++k) \
        acc[ai][bj][m][n] = __builtin_amdgcn_mfma_f32_16x16x32_bf16(Bt[n][k], At[m][k], acc[ai][bj][m][n], 0, 0, 0); __builtin_amdgcn_s_setprio(0); } while (0)
#define PG8_WAIT_V(n) asm volatile("s_waitcnt vmcnt(" #n ")" ::: "memory")
#define PG8_WAIT_L(n) asm volatile("s_waitcnt lgkmcnt(" #n ")" ::: "memory")
#define PG8_BAR __builtin_amdgcn_s_barrier()
#define PG8_SCHED __builtin_amdgcn_sched_barrier(0)
    Unit cur, nxt; int ui = 0;
    if (!S.next(0, cur)) return;
    f32x4 acc[2][2][4][2];
#pragma unroll
    for (int a = 0; a < 2; ++a)
#pragma unroll
        for (int b = 0; b < 2; ++b)
#pragma unroll
            for (int m = 0; m < 4; ++m)
#pragma unroll
                for (int n = 0; n < 2; ++n) acc[a][b][m][n] = (f32x4){0.f, 0.f, 0.f, 0.f};
    bf16x8 At[4][2], B0[2][2], B1[2][2];
    const char* cA = (const char*)g.A + (size_t)cur.pm * tstep + (size_t)cur.k0 * 2; const char* cB = (const char*)g.Bt + (size_t)cur.pn * tstep + (size_t)cur.k0 * 2;
    S.a_ready(cur);
    if constexpr (SP2) {
        PG8_STAGE(PG8_SB(0, 0), cB, voffB); PG8_STAGE(PG8_SB(0, 1), cB + hstep, voffB); PG8_STAGE(PG8_SA(0, 0), cA, voffA); PG8_STAGE(PG8_SA(0, 1), cA + hstep, voffA);
        if (wr == 1) PG8_BAR;
        PG8_WAIT_V(2); PG8_BAR;
        PG8_STAGE(PG8_SB(1, 0), cB + kstep, voffB); PG8_STAGE(PG8_SA(1, 0), cA + kstep, voffA); PG8_STAGE(PG8_SB(1, 1), cB + hstep + kstep, voffB);
        PG8_WAIT_V(6); PG8_BAR;
    } else {
        PG8_STAGE(PG8_SB(0, 0), cB, voffB); PG8_STAGE(PG8_SA(0, 0), cA, voffA); PG8_STAGE(PG8_SB(0, 1), cB + hstep, voffB); PG8_STAGE(PG8_SA(0, 1), cA + hstep, voffA);
        if (wr == 1) PG8_BAR;
        PG8_WAIT_V(4); PG8_BAR;
        PG8_STAGE(PG8_SB(1, 0), cB + kstep, voffB); PG8_STAGE(PG8_SA(1, 0), cA + kstep, voffA); PG8_STAGE(PG8_SB(1, 1), cB + hstep + kstep, voffB);
        PG8_WAIT_V(6); PG8_BAR;
    }
    for (;;) {
        const bool has_next = S.next(ui + 1, nxt);
        const char* nA = has_next ? (const char*)g.A + (size_t)nxt.pm * tstep + (size_t)nxt.k0 * 2 : cA; const char* nB = has_next ? (const char*)g.Bt + (size_t)nxt.pn * tstep + (size_t)nxt.k0 * 2 : cB;
        const int nt = cur.nt;
        for (int t = 0; t < nt; t += 2) {
            const bool last = (t == nt - 2);
            const char* a1 = cA + (size_t)(t + 1) * kstep;
            const char* a2 = last ? nA : cA + (size_t)(t + 2) * kstep; const char* b2 = last ? nB : cB + (size_t)(t + 2) * kstep;
            const char* a3 = a2 + kstep; const char* b3 = b2 + kstep;
            if (last && has_next) S.a_ready(nxt);
            if constexpr (SP2) {
            PG8_LDB(B0, 0, 0); PG8_LDB(B1, 0, 1); PG8_SCHED; PG8_LDA(At, 0, 0); PG8_STAGE(PG8_SA(1, 1), a1 + hstep, voffA);
            PG8_WAIT_V(8); PG8_WAIT_L(0); PG8_BAR; PG8_MMA(0, 0, At, B0); PG8_MMA(0, 1, At, B1); PG8_BAR; PG8_SCHED;
            PG8_LDA(At, 0, 1); PG8_STAGE(PG8_SB(0, 0), b2, voffB); PG8_STAGE(PG8_SB(0, 1), b2 + hstep, voffB); PG8_STAGE(PG8_SA(0, 0), a2, voffA);
            PG8_WAIT_V(8); PG8_WAIT_L(0); PG8_BAR; PG8_MMA(1, 0, At, B0); PG8_MMA(1, 1, At, B1); PG8_BAR; PG8_SCHED;
            PG8_LDB(B0, 1, 0); PG8_LDB(B1, 1, 1); PG8_SCHED; PG8_LDA(At, 1, 0); PG8_STAGE(PG8_SA(0, 1), a2 + hstep, voffA);
            PG8_WAIT_V(8); PG8_WAIT_L(0); PG8_BAR; PG8_MMA(0, 0, At, B0); PG8_MMA(0, 1, At, B1); PG8_BAR; PG8_SCHED;
            PG8_LDA(At, 1, 1); PG8_STAGE(PG8_SB(1, 0), b3, voffB); PG8_STAGE(PG8_SB(1, 1), b3 + hstep, voffB); PG8_STAGE(PG8_SA(1, 0), a3, voffA);
            PG8_WAIT_V(8); PG8_WAIT_L(0); PG8_BAR; PG8_MMA(1, 0, At, B0); PG8_MMA(1, 1, At, B1); PG8_BAR; PG8_SCHED;
            } else {
            PG8_LDB(B0, 0, 0); PG8_SCHED; PG8_LDA(At, 0, 0); PG8_STAGE(PG8_SA(1, 1), a1 + hstep, voffA);
            PG8_WAIT_L(8); PG8_BAR; PG8_WAIT_L(0); PG8_MMA(0, 0, At, B0); PG8_BAR; PG8_SCHED;
            PG8_LDB(B1, 0, 1); PG8_STAGE(PG8_SB(0, 0), b2, voffB);
            PG8_BAR; PG8_WAIT_L(0); PG8_MMA(0, 1, At, B1); PG8_BAR;
            PG8_LDA(At, 0, 1); PG8_STAGE(PG8_SA(0, 0), a2, voffA);
            PG8_BAR; PG8_WAIT_L(0); PG8_MMA(1, 0, At, B0); PG8_BAR; PG8_SCHED;
            PG8_STAGE(PG8_SB(0, 1), b2 + hstep, voffB);
            PG8_WAIT_V(6); PG8_BAR; PG8_MMA(1, 1, At, B1); PG8_BAR;
            PG8_LDB(B0, 1, 0); PG8_SCHED; PG8_LDA(At, 1, 0); PG8_STAGE(PG8_SA(0, 1), a2 + hstep, voffA);
            PG8_WAIT_L(8); PG8_BAR; PG8_WAIT_L(0); PG8_MMA(0, 0, At, B0); PG8_BAR; PG8_SCHED;
            PG8_LDB(B1, 1, 1); PG8_STAGE(PG8_SB(1, 0), b3, voffB);
            PG8_BAR; PG8_WAIT_L(0); PG8_MMA(0, 1, At, B1); PG8_BAR;
            PG8_LDA(At, 1, 1); PG8_STAGE(PG8_SA(1, 0), a3, voffA);
            PG8_BAR; PG8_WAIT_L(0); PG8_MMA(1, 0, At, B0); PG8_BAR; PG8_SCHED;
            PG8_STAGE(PG8_SB(1, 1), b3 + hstep, voffB);
            PG8_WAIT_V(6); PG8_BAR; PG8_MMA(1, 1, At, B1); PG8_BAR;
            }
        }
        if constexpr (ALIGN_EPI) { if (wr == 0) PG8_BAR; }
        if constexpr (!Epi::AFTER_DRAIN) { E(acc, cur, wr, wc, fr, fq); S.done(cur); }
        if (!has_next) break;
#pragma unroll
        for (int a = 0; a < 2; ++a)
#pragma unroll
            for (int b = 0; b < 2; ++b)
#pragma unroll
                for (int m = 0; m < 4; ++m)
#pragma unroll
                    for (int n = 0; n < 2; ++n) acc[a][b][m][n] = (f32x4){0.f, 0.f, 0.f, 0.f};
        cur = nxt; cA = nA; cB = nB; ++ui;
        if constexpr (ALIGN_EPI) { if (wr == 1) PG8_BAR; }
    }
    PG8_WAIT_V(0);
    if constexpr (!ALIGN_EPI) { if (wr == 0) PG8_BAR; }
    PG8_BAR;
#undef PG8_SA
#undef PG8_SB
#undef PG8_STAGE
#undef PG8_LDA
#undef PG8_LDB
#undef PG8_MMA
#undef PG8_WAIT_V
#undef PG8_WAIT_L
#undef PG8_BAR
#undef PG8_SCHED
}
}

namespace att {
constexpr int D = 128, NW = 8, QBLK = 32, KVBLK = 64;
constexpr float SCALE = 0.088388347648318440f;
constexpr float THR = 8.f;
constexpr size_t SHM_V = KVBLK * D * 2, SHM_K = KVBLK * D * 2, SHM_ATTN = 2 * SHM_V + 2 * SHM_K + NW * 64 * 4;
#define KSWZ(row, colB) ((row) * 256 + ((colB) ^ (((row) & 7) << 4)))
#define SBAR() __builtin_amdgcn_sched_barrier(0)
__device__ __forceinline__ int crow(int r, int hi) { return (r & 3) + 8 * (r >> 2) + 4 * hi; }
__device__ __forceinline__ unsigned cvtpk(float lo, float hi) { unsigned r; asm volatile("v_cvt_pk_bf16_f32 %0, %1, %2" : "=v"(r) : "v"(lo), "v"(hi)); return r; }

__device__ __forceinline__ void partialSM(f32x16& p0, f32x16& p1, float& m_reg, float& mn, float& alpha) {
  constexpr float C = SCALE * 1.4426950408889634f;
  float pmax = p0[0];
#pragma unroll
  for (int r = 1; r < 16; ++r) pmax = fmaxf(pmax, p0[r]);
#pragma unroll
  for (int r = 0; r < 16; ++r) pmax = fmaxf(pmax, p1[r]);
  { auto rr = __builtin_amdgcn_permlane32_swap(__float_as_uint(pmax), __float_as_uint(pmax), false, false);
    pmax = fmaxf(__uint_as_float(rr[0]), __uint_as_float(rr[1])); }
  if (__builtin_expect(__all(pmax - m_reg <= THR / SCALE), 1)) { mn = m_reg; alpha = 1.f; }
  else { mn = fmaxf(m_reg, pmax); alpha = __builtin_amdgcn_exp2f((m_reg - mn) * C); m_reg = mn; }
  float mnC = -mn * C;
#pragma unroll
  for (int r = 0; r < 16; ++r) p0[r] = fmaf(p0[r], C, mnC);
#pragma unroll
  for (int r = 0; r < 16; ++r) p1[r] = fmaf(p1[r], C, mnC);
#pragma unroll
  for (int r = 0; r < 16; ++r) p0[r] = __builtin_amdgcn_exp2f(p0[r]);
}
__device__ __forceinline__ void finishSM(f32x16& p0, f32x16& p1, float alpha, float& l_reg, bf16x8& pa0, bf16x8& pa1, bf16x8& pa2, bf16x8& pa3) {
#pragma unroll
  for (int r = 0; r < 16; ++r) p1[r] = __builtin_amdgcn_exp2f(p1[r]);
  float ps = 0;
#pragma unroll
  for (int r = 0; r < 16; ++r) ps += p0[r];
#pragma unroll
  for (int r = 0; r < 16; ++r) ps += p1[r];
  { auto rr = __builtin_amdgcn_permlane32_swap(__float_as_uint(ps), __float_as_uint(ps), false, false);
    ps = __uint_as_float(rr[0]) + __uint_as_float(rr[1]); }
  l_reg = l_reg * alpha + ps;
#define PK4(P, BASE, OUT) do { unsigned a0 = cvtpk(P[BASE + 0], P[BASE + 1]), a1 = cvtpk(P[BASE + 2], P[BASE + 3]);   \
    unsigned b0 = cvtpk(P[BASE + 4], P[BASE + 5]), b1 = cvtpk(P[BASE + 6], P[BASE + 7]);                              \
    auto r0 = __builtin_amdgcn_permlane32_swap(a0, b0, false, false); auto r1 = __builtin_amdgcn_permlane32_swap(a1, b1, false, false); \
    u32x4 w = {r0[0], r1[0], r0[1], r1[1]}; OUT = __builtin_bit_cast(bf16x8, w); } while (0)
  PK4(p0, 0, pa0); PK4(p0, 8, pa1); PK4(p1, 0, pa2); PK4(p1, 8, pa3);
#undef PK4
}
__device__ __forceinline__ void qkt(f32x16& p0, f32x16& p1, const char* Ks, const bf16x8* qr, int r32, int hi) {
  p0 = f32x16{}; p1 = f32x16{};
#pragma unroll
  for (int d0 = 0; d0 < 8; ++d0) { int cb = (d0 * 16 + hi * 8) * 2;
    bf16x8 b0 = *reinterpret_cast<const bf16x8*>(Ks + KSWZ(r32, cb));
    bf16x8 b1 = *reinterpret_cast<const bf16x8*>(Ks + KSWZ(32 + r32, cb));
    p0 = __builtin_amdgcn_mfma_f32_32x32x16_bf16(b0, qr[d0], p0, 0, 0, 0);
    p1 = __builtin_amdgcn_mfma_f32_32x32x16_bf16(b1, qr[d0], p1, 0, 0, 0); }
}
__device__ __forceinline__ int v_st(int k, int c) { const int kk = (k & ~0xC) | ((k & 4) << 1) | ((k & 8) >> 1); return ((kk >> 3) * 4 + (c >> 5)) * 512 + ((kk & 7) * 32 + (c & 31)) * 2; }
__device__ __forceinline__ int v_rd_base(int lane) { return ((lane & 3) << 3) | (((lane >> 2) & 3) << 6) | (((lane >> 4) & 1) << 5) | (((lane >> 5) & 1) << 8); }
constexpr int v_rd_off(int d0, int ks, int half) { return d0 * 512 + ks * 4096 + half * 2048; }
template <int OFF> __device__ __forceinline__ s16x4 tr_read(int vb) {
  s16x4 r; asm volatile("ds_read_b64_tr_b16 %0, %1 offset:%2" : "=&v"(r) : "v"(vb), "i"(OFF) : "memory"); return r;
}
template <int D0> __device__ __forceinline__ void pv_one(f32x16& od, int vb, bf16x8 pa0, bf16x8 pa1, bf16x8 pa2, bf16x8 pa3) {
  const s16x4 l0 = tr_read<v_rd_off(D0, 0, 0)>(vb), h0 = tr_read<v_rd_off(D0, 0, 1)>(vb), l1 = tr_read<v_rd_off(D0, 1, 0)>(vb), h1 = tr_read<v_rd_off(D0, 1, 1)>(vb);
  const s16x4 l2 = tr_read<v_rd_off(D0, 2, 0)>(vb), h2 = tr_read<v_rd_off(D0, 2, 1)>(vb), l3 = tr_read<v_rd_off(D0, 3, 0)>(vb), h3 = tr_read<v_rd_off(D0, 3, 1)>(vb);
  asm volatile("s_waitcnt lgkmcnt(0)" ::: "memory"); SBAR();
#define PK(L, H) (bf16x8){L[0], L[1], L[2], L[3], H[0], H[1], H[2], H[3]}
  od = __builtin_amdgcn_mfma_f32_32x32x16_bf16(pa0, PK(l0, h0), od, 0, 0, 0);
  od = __builtin_amdgcn_mfma_f32_32x32x16_bf16(pa1, PK(l1, h1), od, 0, 0, 0);
  od = __builtin_amdgcn_mfma_f32_32x32x16_bf16(pa2, PK(l2, h2), od, 0, 0, 0);
  od = __builtin_amdgcn_mfma_f32_32x32x16_bf16(pa3, PK(l3, h3), od, 0, 0, 0);
#undef PK
}
__device__ __forceinline__ void pv_d0(f32x16* o, int vb, bf16x8 pa0, bf16x8 pa1, bf16x8 pa2, bf16x8 pa3) {
  pv_one<0>(o[0], vb, pa0, pa1, pa2, pa3); pv_one<1>(o[1], vb, pa0, pa1, pa2, pa3); pv_one<2>(o[2], vb, pa0, pa1, pa2, pa3); pv_one<3>(o[3], vb, pa0, pa1, pa2, pa3);
}
__device__ __forceinline__ void attn_dense_body(const bf16_t* __restrict__ Qb, const bf16_t* __restrict__ Kh, const bf16_t* __restrict__ Vh,
                                                bf16_t* __restrict__ Ob, int seq, int ldq, int ldk, int ldo, char* lds, const float* __restrict__ qn, const float* __restrict__ rope0) {
  const int tid = tid_fresh(), wid = tid >> 6, lane = tid & 63, r32 = lane & 31, hi = lane >> 5;
  char* V_lds = lds; char* K_lds = lds + 2 * SHM_V;
  float* ws = (float*)(lds + 2 * SHM_V + 2 * SHM_K) + wid * 64; float* li_l = ws; float* al_l = ws + 32;
  float m_reg = -1e30f, l_reg = 0; f32x16 o[4] = {}; bf16x8 qr[8];
  const bf16_t* Qw = Qb + (long)(wid * QBLK + r32) * ldq + hi * 8;
#pragma unroll
  for (int d0 = 0; d0 < 8; ++d0) qr[d0] = *reinterpret_cast<const bf16x8*>(Qw + d0 * 16);
  {
    float qf[8][8]; float ss = 0.f;
#pragma unroll
    for (int d0 = 0; d0 < 8; ++d0)
#pragma unroll
      for (int e = 0; e < 8; ++e) { qf[d0][e] = bf2f((unsigned short)qr[d0][e]); ss += qf[d0][e] * qf[d0][e]; }
    ss += __shfl_xor(ss, 32);
    const float rstd = 1.0f / sqrtf(ss * (1.0f / D) + EPS);
#pragma unroll
    for (int d0 = 0; d0 < 8; ++d0) { const f32x4 g0 = *(const f32x4*)(qn + d0 * 16 + hi * 8), g1 = *(const f32x4*)(qn + d0 * 16 + hi * 8 + 4);
#pragma unroll
      for (int e = 0; e < 8; ++e) qf[d0][e] *= rstd * (e < 4 ? g0[e & 3] : g1[e & 3]); }
    if (rope0 != nullptr) { const float* rp = rope0 + (long)(wid * QBLK + r32) * 128 + hi * 8;
#pragma unroll
      for (int ax = 0; ax < 2; ++ax)
#pragma unroll
        for (int dl = 0; dl < 2; ++dl) { const int d0 = 4 * ax + dl;
          const f32x4 c0 = *(const f32x4*)(rp + ax * 64 + dl * 16), c1 = *(const f32x4*)(rp + ax * 64 + dl * 16 + 4), s0 = *(const f32x4*)(rp + ax * 64 + 32 + dl * 16), s1 = *(const f32x4*)(rp + ax * 64 + 32 + dl * 16 + 4);
#pragma unroll
          for (int e = 0; e < 8; ++e) { const float c = e < 4 ? c0[e & 3] : c1[e & 3], sn = e < 4 ? s0[e & 3] : s1[e & 3]; const float x1 = qf[d0][e], x2 = qf[d0 + 2][e];
            qf[d0][e] = x1 * c - x2 * sn; qf[d0 + 2][e] = x2 * c + x1 * sn; } } }
#pragma unroll
    for (int d0 = 0; d0 < 8; ++d0) { u32x4 w; w.x = cvt_pk_bf16(qf[d0][0], qf[d0][1]); w.y = cvt_pk_bf16(qf[d0][2], qf[d0][3]); w.z = cvt_pk_bf16(qf[d0][4], qf[d0][5]); w.w = cvt_pk_bf16(qf[d0][6], qf[d0][7]);
      qr[d0] = __builtin_bit_cast(bf16x8, w); }
  }
  const int sr = tid >> 4, sc = (tid & 15) * 8, vst0 = v_st(sr, sc), vst1 = v_st(32 + sr, sc);
  const int vb0 = (int)(uintptr_t)V_lds + v_rd_base(lane);
  bf16x8 e_vs0, e_vs1, e_ks0, e_ks1, o_vs0, o_vs1, o_ks0, o_ks1;
#define SLOAD_E(k0) do { e_vs0 = *reinterpret_cast<const bf16x8*>(&Vh[(long)((k0) + sr) * ldk + sc]); e_vs1 = *reinterpret_cast<const bf16x8*>(&Vh[(long)((k0) + 32 + sr) * ldk + sc]); \
    e_ks0 = *reinterpret_cast<const bf16x8*>(&Kh[(long)((k0) + sr) * ldk + sc]); e_ks1 = *reinterpret_cast<const bf16x8*>(&Kh[(long)((k0) + 32 + sr) * ldk + sc]); } while (0)
#define SLOAD_O(k0) do { o_vs0 = *reinterpret_cast<const bf16x8*>(&Vh[(long)((k0) + sr) * ldk + sc]); o_vs1 = *reinterpret_cast<const bf16x8*>(&Vh[(long)((k0) + 32 + sr) * ldk + sc]); \
    o_ks0 = *reinterpret_cast<const bf16x8*>(&Kh[(long)((k0) + sr) * ldk + sc]); o_ks1 = *reinterpret_cast<const bf16x8*>(&Kh[(long)((k0) + 32 + sr) * ldk + sc]); } while (0)
#define SWRITE_E(b) do { *(bf16x8*)(V_lds + (b) * SHM_V + vst0) = e_vs0; *(bf16x8*)(V_lds + (b) * SHM_V + vst1) = e_vs1; int kc = sc * 2; \
    *(bf16x8*)(K_lds + (b) * SHM_K + KSWZ(sr, kc)) = e_ks0; *(bf16x8*)(K_lds + (b) * SHM_K + KSWZ(32 + sr, kc)) = e_ks1; } while (0)
#define SWRITE_O(b) do { *(bf16x8*)(V_lds + (b) * SHM_V + vst0) = o_vs0; *(bf16x8*)(V_lds + (b) * SHM_V + vst1) = o_vs1; int kc = sc * 2; \
    *(bf16x8*)(K_lds + (b) * SHM_K + KSWZ(sr, kc)) = o_ks0; *(bf16x8*)(K_lds + (b) * SHM_K + KSWZ(32 + sr, kc)) = o_ks1; } while (0)
#define SWAIT() asm volatile("s_waitcnt vmcnt(4)" ::: "memory")
#define RESC(a) do { if (__any((a) < 1.f)) { if (hi == 0) al_l[r32] = (a); asm volatile("s_waitcnt lgkmcnt(0)" ::: "memory"); \
    _Pragma("unroll") for (int d = 0; d < 4; ++d) _Pragma("unroll") for (int r = 0; r < 16; ++r) o[d][r] *= al_l[crow(r, hi)]; } } while (0)
  f32x16 pA0, pA1, pB0, pB1; float mnA, mnB, alA, alB; bf16x8 pa0, pa1, pa2, pa3; const int NT = seq / KVBLK;
  SLOAD_E(0); asm volatile("s_waitcnt vmcnt(0)" ::: "memory"); SWRITE_E(0); __syncthreads();
  qkt(pA0, pA1, K_lds, qr, r32, hi); partialSM(pA0, pA1, m_reg, mnA, alA);
  SLOAD_O(KVBLK); if (2 < NT) SLOAD_E(2 * KVBLK);
  SWAIT(); SWRITE_O(1); __syncthreads();
  for (int j = 1; j + 1 < NT; j += 2) {
    SBAR(); qkt(pB0, pB1, K_lds + SHM_K, qr, r32, hi);
    finishSM(pA0, pA1, alA, l_reg, pa0, pa1, pa2, pa3); SBAR();
    SLOAD_O((j + 2) * KVBLK); SBAR();
    pv_d0(o, vb0, pa0, pa1, pa2, pa3); partialSM(pB0, pB1, m_reg, mnB, alB);
    __syncthreads(); SWAIT(); SWRITE_E(0);
    RESC(alB); __syncthreads();
    SBAR(); qkt(pA0, pA1, K_lds, qr, r32, hi);
    finishSM(pB0, pB1, alB, l_reg, pa0, pa1, pa2, pa3); SBAR();
    if (j + 3 < NT) SLOAD_E((j + 3) * KVBLK); SBAR();
    pv_d0(o, vb0 + (int)SHM_V, pa0, pa1, pa2, pa3); partialSM(pA0, pA1, m_reg, mnA, alA);
    __syncthreads(); SWAIT(); SWRITE_O(1);
    RESC(alA); __syncthreads();
  }
  SBAR(); qkt(pB0, pB1, K_lds + SHM_K, qr, r32, hi);
  finishSM(pA0, pA1, alA, l_reg, pa0, pa1, pa2, pa3); SBAR();
  pv_d0(o, vb0, pa0, pa1, pa2, pa3); partialSM(pB0, pB1, m_reg, mnB, alB);
  __syncthreads(); RESC(alB);
  finishSM(pB0, pB1, alB, l_reg, pa0, pa1, pa2, pa3); SBAR();
  pv_d0(o, vb0 + (int)SHM_V, pa0, pa1, pa2, pa3);
  if (hi == 0) li_l[r32] = l_reg; asm volatile("s_waitcnt lgkmcnt(0)" ::: "memory");
  float rli[16];
#pragma unroll
  for (int r = 0; r < 16; ++r) rli[r] = __builtin_amdgcn_rcpf(li_l[crow(r, hi)]);
  bf16_t* Ow = Ob + (long)(wid * QBLK) * ldo;
#pragma unroll
  for (int r = 0; r < 16; ++r) { int orow = crow(r, hi);
#pragma unroll
    for (int d0 = 0; d0 < 4; ++d0) Ow[(long)orow * ldo + d0 * 32 + r32] = (bf16_t)(cvt_pk_bf16(o[d0][r] * rli[r], 0.f) & 0xffffu); }
#undef SLOAD_E
#undef SLOAD_O
#undef SWRITE_E
#undef SWRITE_O
#undef SWAIT
#undef RESC
}
}

#define XB_TMO      128
#define XB_XCNT(j)  (256  + 64 * (j))
#define XB_XSUB(j)  (1280 + 64 * (j))
#define XB_XGEN(j)  (2304 + 64 * (j))
#define XB_TOP      3328
#define XB_TOPGEN   3392
#define XCD_BAR_WORDS 3456
#define XB_SPIN_CAP (1u << 18)
__device__ __forceinline__ unsigned xb_ld(unsigned* p)              { return __hip_atomic_load(p, __ATOMIC_RELAXED, __HIP_MEMORY_SCOPE_AGENT); }
__device__ __forceinline__ unsigned xb_add(unsigned* p, unsigned v) { return __hip_atomic_fetch_add(p, v, __ATOMIC_RELAXED, __HIP_MEMORY_SCOPE_AGENT); }
__device__ __forceinline__ unsigned xb_xcc_id() { return (unsigned)__builtin_amdgcn_s_getreg((3 << 11) | 20) & 0xFu; }
#define XB_SPIN(cond, bar) do { unsigned _sp = 0; while (cond) { __builtin_amdgcn_s_sleep(1); \
    if ((++_sp & 255u) == 0u) { if (xb_ld(&(bar)[XB_TMO])) break; if (_sp > XB_SPIN_CAP) { atomicAdd(&(bar)[XB_TMO], 1u); break; } } } } while (0)
struct XcdBarrier { unsigned* bar; unsigned x; volatile LAS unsigned* st; };
__device__ __forceinline__ XcdBarrier xcd_barrier_post(unsigned* bar, volatile LAS unsigned* st) {
    XcdBarrier b; b.bar = bar; b.x = xb_xcc_id(); b.st = st;
    if (threadIdx.x == 0) (void)xb_add(&bar[XB_XCNT(b.x)], 1u);
    return b;
}
__device__ __forceinline__ void xcd_barrier_complete(unsigned* bar, unsigned x, unsigned& nloc, unsigned& nx) {
    const unsigned G = gridDim.x * gridDim.y * gridDim.z;
    unsigned sum, cnt, mine, sp = 0u;
    for (;;) {
        sum = 0u; cnt = 0u; mine = 0u;
#pragma unroll
        for (unsigned j = 0; j < 16; ++j) { const unsigned c = xb_ld(&bar[XB_XCNT(j)]); sum += c; cnt += (c > 0u) ? 1u : 0u; mine = (j == x) ? c : mine; }
        if (sum == G) break;
        __builtin_amdgcn_s_sleep(1);
        if ((++sp & 255u) == 0u) { if (xb_ld(&bar[XB_TMO])) break; if (sp > XB_SPIN_CAP) { atomicAdd(&bar[XB_TMO], 1u); break; } }
    }
    nloc = mine > 0u ? mine : 1u; nx = cnt > 0u ? cnt : 1u;
}
__device__ __forceinline__ void xcd_barrier(const XcdBarrier& b) {
    asm volatile("s_waitcnt vmcnt(0)" ::: "memory");
    __syncthreads();
    if (threadIdx.x == 0) {
        unsigned* bar = b.bar;
        __builtin_amdgcn_s_waitcnt(0);
        unsigned nloc = b.st[0], nx = b.st[1];
        if (nloc == 0u) { xcd_barrier_complete(bar, b.x, nloc, nx); b.st[0] = nloc; b.st[1] = nx; }
        const unsigned old = xb_add(&bar[XB_XSUB(b.x)], 1u);
        const unsigned gen = old / nloc;
        if (old + 1u == (gen + 1u) * nloc) {
            __builtin_amdgcn_fence(__ATOMIC_RELEASE, "agent");
            asm volatile("s_waitcnt vmcnt(0)" ::: "memory");
            const unsigned og = xb_add(&bar[XB_TOP], 1u);
            const unsigned tg = og / nx;
            if (og + 1u == (tg + 1u) * nx) xb_add(&bar[XB_TOPGEN], 1u);
            else XB_SPIN(xb_ld(&bar[XB_TOPGEN]) == tg, bar);
            __builtin_amdgcn_fence(__ATOMIC_ACQUIRE, "agent");
            xb_add(&bar[XB_XGEN(b.x)], 1u);
            asm volatile("s_waitcnt vmcnt(0)" ::: "memory");
        } else {
            XB_SPIN(xb_ld(&bar[XB_XGEN(b.x)]) == gen, bar);
            __builtin_amdgcn_fence(__ATOMIC_ACQUIRE, "agent");
            asm volatile("s_waitcnt vmcnt(0)" ::: "memory");
        }
    }
    __syncthreads();
}

struct Args {
    const float* x_prompt; const float* x_sample; const float* cache_k; const float* cache_v; const float* st_f; const float* st_b; const float* c; const float* c_ctx;
    const float* w_mod; const float* b_mod; const float* norm1; const float* w_in; const float* q_norm; const float* k_norm; const float* wg_f; const float* bg_f;
    const float* wg_b; const float* bg_b; const float* gla_norm; const float* w_out; const float* norm2; const float* w_up; const float* w_down;
    float* out; unsigned char* ws; int ph_lo, ph_hi;
};
static_assert(sizeof(Args) == 25 * 8 + 8, "Args has no padding");
typedef const __attribute__((address_space(4))) Args* KArgsP;
__device__ __forceinline__ KArgsP ka_get() { KArgsP p = (KArgsP)__builtin_amdgcn_kernarg_segment_ptr(); asm volatile("" : "+s"(p)); return p; }
__device__ __forceinline__ float* mk_out_ptr() { return ka_get()->out; }

__device__ __forceinline__ float wave_sum(float v) {
#pragma unroll
    for (int o = 1; o < 64; o <<= 1) v += __shfl_xor(v, o);
    return v;
}
__device__ __forceinline__ float half_sum(float v) {
#pragma unroll
    for (int o = 1; o < 32; o <<= 1) v += __shfl_xor(v, o);
    return v;
}
__device__ __forceinline__ float silu_f(float x) { return x / (1.f + __expf(-x)); }
__device__ __forceinline__ float logsigmoid_f(float z) { return fminf(z, 0.f) - log1pf(__expf(-fabsf(z))); }

__device__ __forceinline__ int win_row(int ncol) {
    if (ncol >= C_QG && ncol < C_KG) return C_QG + ((ncol - C_QG) >> 6) * 256 + ((ncol - C_QG) & 63);
    if (ncol >= C_KG && ncol < C_VG) return C_QG + ((ncol - C_KG) >> 6) * 256 + 64 + ((ncol - C_KG) & 63);
    if (ncol >= C_VG && ncol < C_OG) return C_QG + ((ncol - C_VG) >> 7) * 256 + 128 + ((ncol - C_VG) & 127);
    if (ncol < C_K || ncol >= C_V + 2 * HD) return ncol;
    const int hh = (ncol - C_K) >> 7, d = (ncol - C_K) & 127, half64 = d >> 6, r = d & 63, nn = r >> 5, r5 = r & 31, g = half64 * 8 + (r5 >> 2), j = r5 & 3;
    return C_K + hh * 128 + 32 * (g >> 2) + 8 * (g & 3) + 4 * nn + j;
}
template <bool REMAP>
__device__ __forceinline__ void p0_transpose_item(const float* W, int K, int N, bf16_t* WT, LAS float* scr, int item, int lane) {
    const int nblk = N / 32, kb = item / nblk, nb = item % nblk, k0 = 64 * kb, n0 = 32 * nb;
#pragma unroll 8
    for (int i = 0; i < 32; ++i) { const int kk = 2 * i + (lane >> 5); scr[kk * 33 + (lane & 31)] = PRO_NT ? __builtin_nontemporal_load(&W[(size_t)(k0 + kk) * N + n0 + (lane & 31)]) : W[(size_t)(k0 + kk) * N + n0 + (lane & 31)]; }
    LDS_WAIT(); asm volatile("" ::: "memory");
    const int c = lane & 7;
#pragma unroll
    for (int j = 0; j < 4; ++j) { const int n = (lane >> 3) + 8 * j; const LAS float* s = scr + (8 * c) * 33 + n;
        u32x4 o; o.x = pk2(s[0 * 33], s[1 * 33]); o.y = pk2(s[2 * 33], s[3 * 33]); o.z = pk2(s[4 * 33], s[5 * 33]); o.w = pk2(s[6 * 33], s[7 * 33]);
        if (PRO_NT) __builtin_nontemporal_store(o, (u32x4*)(WT + (size_t)(REMAP ? win_row(n0 + n) : n0 + n) * K + k0 + 8 * c)); else *(u32x4*)(WT + (size_t)(REMAP ? win_row(n0 + n) : n0 + n) * K + k0 + 8 * c) = o; }
    LDS_WAIT(); asm volatile("" ::: "memory");
}

constexpr int CW_IN = (DM / 64) * (PROJ_W / 32), CW_OUT = (DM / 64) * (DM / 32), CW_UP = (DM / 64) * (DFF / 32), CW_DN = (DFF / 64) * (DM / 32), CW_IL = CW_IN + CW_OUT + CW_UP + CW_DN;
__device__ __forceinline__ void convert_weights(KArgsP ap, LAS unsigned char* lds, int lo, int hi, int part, int nparts) {
    const int tid = tid_fresh(), lane = tid & 63, wave = __builtin_amdgcn_readfirstlane(tid >> 6);
    unsigned char* ws = ap->ws;
    LAS float* scr = (LAS float*)(lds + wave * 16384);
    for (int it = lo + part * 8 + wave; it < hi; it += nparts * 8) {
        const int l = it / CW_IL; int r = it % CW_IL;
        if (r < CW_IN) { p0_transpose_item<true>(ap->w_in + (size_t)l * DM * PROJ_W, DM, PROJ_W, (bf16_t*)(ws + WS_WIN) + (size_t)l * PROJ_P * DM, scr, r, lane); continue; } r -= CW_IN;
        if (r < CW_OUT) { p0_transpose_item<false>(ap->w_out + (size_t)l * DM * DM, DM, DM, (bf16_t*)(ws + WS_WOUT) + (size_t)l * DM * DM, scr, r, lane); continue; } r -= CW_OUT;
        if (r < CW_UP) { p0_transpose_item<false>(ap->w_up + (size_t)l * DM * DFF, DM, DFF, (bf16_t*)(ws + WS_WUP) + (size_t)l * DFF * DM, scr, r, lane); continue; } r -= CW_UP;
        p0_transpose_item<false>(ap->w_down + (size_t)l * DFF * DM, DFF, DM, (bf16_t*)(ws + WS_WDN) + (size_t)l * DM * DFF, scr, r, lane);
    }
}

__device__ __forceinline__ void phase_prologue(KArgsP ap, LAS unsigned char* lds, int G) {
    const int tid = tid_fresh(), lane = tid & 63, wave = __builtin_amdgcn_readfirstlane(tid >> 6);
    unsigned char* ws = ap->ws;
    float* MOD = (float*)(ws + WS_MOD);
    {
        LAS float* sv = (LAS float*)lds;
        LAS float* red = (LAS float*)(lds + 40960);
        for (int i = tid; i < NGRP * DM; i += 512) { const int v = i / DM, k = i % DM; const float x = (v == 0) ? ap->c_ctx[k] : ap->c[(v - 1) * DM + k]; sv[i] = silu_f(x); }
        __syncthreads();
        const int kg = tid >> 4, cl = tid & 15;
        for (int it = blockIdx.x; it < DEPTH * (6 * DM / 64); it += G) {
            const int l = it / (6 * DM / 64), n0 = (it % (6 * DM / 64)) * 64;
            const float* wp = ap->w_mod + ((size_t)l * DM + kg * 64) * (6 * DM) + n0 + 4 * cl;
            f32x4 acc[NGRP];
#pragma unroll
            for (int v = 0; v < NGRP; ++v) acc[v] = (f32x4){0.f, 0.f, 0.f, 0.f};
#pragma unroll 8
            for (int kk = 0; kk < 64; ++kk) { const f32x4 w = PRO_NT ? __builtin_nontemporal_load((const f32x4*)(wp + (size_t)kk * (6 * DM))) : *(const f32x4*)(wp + (size_t)kk * (6 * DM));
#pragma unroll
                for (int v = 0; v < NGRP; ++v) acc[v] += w * sv[v * DM + kg * 64 + kk]; }
#pragma unroll
            for (int v = 0; v < NGRP; ++v) *(LAS f32x4*)(red + (kg * NGRP + v) * 64 + 4 * cl) = acc[v];
            __syncthreads();
            if (tid < NGRP * 64) { const int v = tid >> 6, n = tid & 63; float s = 0.f;
                for (int g2 = 0; g2 < 32; ++g2) s += red[(g2 * NGRP + v) * 64 + n];
                MOD[((size_t)l * NGRP + v) * (6 * DM) + n0 + n] = s + ap->b_mod[(size_t)l * (6 * DM) + n0 + n]; }
            __syncthreads();
        }
    }
    __syncthreads();
    const int gw = blockIdx.x * 8 + wave, NGW = G * 8;
    const size_t gt = (size_t)blockIdx.x * 512 + tid, NGT = (size_t)G * 512;
    convert_weights(ap, lds, 0, (CONV_TAILS ? 2 : 4) * CW_IL, blockIdx.x, G);
    {
        constexpr size_t PADV = (size_t)(PROJ_P - PROJ_W) * DM * 2 / 16;
        for (size_t i = gt; i < DEPTH * PADV; i += NGT) { const size_t l = i / PADV, r = i % PADV;
            *(u32x4*)(ws + WS_WIN + (l * PROJ_P + PROJ_W) * (size_t)DM * 2 + r * 16) = (u32x4){0u, 0u, 0u, 0u}; }
    }
    {
        float* RP = (float*)(ws + WS_ROPE);
        for (size_t i = gt; i < (size_t)S_LAT * 64; i += NGT) { const int t = (int)(i >> 6), j = (int)(i & 63), ax = j >> 5, fi = j & 31;
            const float pos = (float)(ax == 0 ? (t >> 6) : (t & 63));
            const float inv = exp2f(-(float)fi * (13.287712379549449f / 32.f));
            const float rev = pos * inv * 0.15915494309189535f; const float fr = rev - floorf(rev);
            RP[(size_t)t * 128 + ax * 64 + fi] = __builtin_amdgcn_cosf(fr); RP[(size_t)t * 128 + ax * 64 + 32 + fi] = __builtin_amdgcn_sinf(fr); }
    }
    {
        constexpr size_t NV = (size_t)NB_LAT * DEPTH * PAST * KVW / 4;
        for (size_t i = gt; i < 2 * NV; i += NGT) { const bool isv = i >= NV; const size_t j = isv ? i - NV : i;
            const size_t e = j * 4, b = e / ((size_t)DEPTH * PAST * KVW), rem = e % ((size_t)DEPTH * PAST * KVW), l = rem / ((size_t)PAST * KVW), sc = rem % ((size_t)PAST * KVW);
            const f32x4 v = *(const f32x4*)((isv ? ap->cache_v : ap->cache_k) + e);
            u32x2 o; o.x = pk2(v[0], v[1]); o.y = pk2(v[2], v[3]);
            *(u32x2*)((bf16_t*)(ws + (isv ? WS_VL : WS_KL)) + ((l * NB_LAT + b) * S_KVL) * KVW + sc) = o; }
    }
}

__device__ __forceinline__ void phase_norm(bf16_t* XB, const bf16_t* side, const float* nw, const float* mod_l  , int off_shift, int off_scale, bf16_t* H, int G, bool from_inputs = false) {
    const int tid = tid_fresh(), lane = tid & 63, wave = __builtin_amdgcn_readfirstlane(tid >> 6);
    const int gw = blockIdx.x * 8 + wave, NGW = G * 8;
    constexpr int RB = 3;
    int cur_grp = -1; f32x4 gm[4][2], sh[4][2];
    for (int row = gw * RB; row < M; row += NGW * RB) {
        u32x4 xv[RB][4];
        if (from_inputs) {
            KArgsP ka = ka_get();
#pragma unroll
            for (int rr = 0; rr < RB; ++rr) { const int r = row + rr; const float* src = (r < M_CTX ? ka->x_prompt + (size_t)r * DM : ka->x_sample + (size_t)(r - M_CTX) * DM) + 8 * lane;
                f32x4 fa[4], fb[4];
#pragma unroll
                for (int j = 0; j < 4; ++j) { fa[j] = __builtin_nontemporal_load((const f32x4*)(src + 512 * j)); fb[j] = __builtin_nontemporal_load((const f32x4*)(src + 512 * j + 4)); }
#pragma unroll
                for (int j = 0; j < 4; ++j) { u32x4 w; w.x = cvt_pk_bf16(fa[j][0], fa[j][1]); w.y = cvt_pk_bf16(fa[j][2], fa[j][3]); w.z = cvt_pk_bf16(fb[j][0], fb[j][1]); w.w = cvt_pk_bf16(fb[j][2], fb[j][3]);
                    xv[rr][j] = w; *(u32x4*)(XB + (size_t)r * DM + 8 * lane + 512 * j) = w; } } }
        else {
#pragma unroll
        for (int rr = 0; rr < RB; ++rr)
#pragma unroll
            for (int j = 0; j < 4; ++j) xv[rr][j] = *(const u32x4*)(XB + (size_t)(row + rr) * DM + 8 * lane + 512 * j); }
        if (side != nullptr && row + RB > M_CTX) {
#pragma unroll
            for (int rr = 0; rr < RB; ++rr) { const int r = row + rr;
                if (r >= M_CTX) {
#pragma unroll
                    for (int j = 0; j < 4; ++j) { const u32x4 sv = __builtin_nontemporal_load((const u32x4*)(side + (size_t)(r - M_CTX) * DM + 8 * lane + 512 * j)); u32x4 w = xv[rr][j];
                        w.x = cvt_pk_bf16(bflo(w.x) + bflo(sv.x), bfhi(w.x) + bfhi(sv.x)); w.y = cvt_pk_bf16(bflo(w.y) + bflo(sv.y), bfhi(w.y) + bfhi(sv.y));
                        w.z = cvt_pk_bf16(bflo(w.z) + bflo(sv.z), bfhi(w.z) + bfhi(sv.z)); w.w = cvt_pk_bf16(bflo(w.w) + bflo(sv.w), bfhi(w.w) + bfhi(sv.w));
                        xv[rr][j] = w; *(u32x4*)(XB + (size_t)r * DM + 8 * lane + 512 * j) = w; } } } }
#pragma unroll
        for (int rr = 0; rr < RB; ++rr) { const int r = row + rr;
            const int grp = r < M_CTX ? 0 : 1 + (r - M_CTX) / S_LAT;
            if (grp != cur_grp) { cur_grp = grp; const float* mp = mod_l + (size_t)grp * (6 * DM);
#pragma unroll
                for (int j = 0; j < 4; ++j)
#pragma unroll
                    for (int q = 0; q < 2; ++q) { const int c = 8 * lane + 512 * j + 4 * q; const f32x4 w = *(const f32x4*)(nw + c), sc = *(const f32x4*)(mp + off_scale + c);
                        gm[j][q] = w * (sc + 1.0f); sh[j][q] = *(const f32x4*)(mp + off_shift + c); } }
            float x[4][8]; float ss = 0.f;
#pragma unroll
            for (int j = 0; j < 4; ++j) { const u32x4 w = xv[rr][j];
                x[j][0] = bflo(w.x); x[j][1] = bfhi(w.x); x[j][2] = bflo(w.y); x[j][3] = bfhi(w.y); x[j][4] = bflo(w.z); x[j][5] = bfhi(w.z); x[j][6] = bflo(w.w); x[j][7] = bfhi(w.w);
#pragma unroll
                for (int e = 0; e < 8; ++e) ss += x[j][e] * x[j][e]; }
            const float rstd = 1.0f / sqrtf(wave_sum(ss) * (1.0f / DM) + EPS);
            bf16_t* hr = H + (size_t)r * DM;
#pragma unroll
            for (int j = 0; j < 4; ++j) { float y[8];
#pragma unroll
                for (int e = 0; e < 8; ++e) y[e] = x[j][e] * rstd * gm[j][e >> 2][e & 3] + sh[j][e >> 2][e & 3];
                u32x4 o; o.x = cvt_pk_bf16(y[0], y[1]); o.y = cvt_pk_bf16(y[2], y[3]); o.z = cvt_pk_bf16(y[4], y[5]); o.w = cvt_pk_bf16(y[6], y[7]);
                *(u32x4*)(hr + 8 * lane + 512 * j) = o; }
        }
    }
}

__device__ __forceinline__ void phase_prep(KArgsP a, int l, int G, int dry) {
    const int tid = tid_fresh(), lane = tid & 63, wave = __builtin_amdgcn_readfirstlane(tid >> 6);
    unsigned char* ws = a->ws;
    bf16_t* PROJ = (bf16_t*)(ws + WS_PROJ);
    const float* RP = (const float*)(ws + WS_ROPE);
    const int gw = blockIdx.x * 8 + wave, NGW = G * 8;
    const int j16 = lane & 15, sg = lane >> 4, d0 = 8 * j16;
    f32x4 gq[2], gk[2];
    { const float* qn = a->q_norm + l * HD + d0; const float* kn = a->k_norm + l * HD + d0; gq[0] = *(const f32x4*)qn; gq[1] = *(const f32x4*)(qn + 4); gk[0] = *(const f32x4*)kn; gk[1] = *(const f32x4*)(kn + 4); }
    const float sgn = (j16 & 4) ? 1.f : -1.f;
    const int rpo = (j16 >> 3) * 64 + 8 * (j16 & 3);
    float* out = a->out;
    constexpr int RB = 2;
    for (int row = gw * RB; row < M; row += NGW * RB) {
        u32x4 wv[RB][3]; f32x4 rc[RB][2], rs[RB][2];
#pragma unroll
        for (int rr = 0; rr < RB; ++rr) { const int r = row + rr; const bf16_t* pr = PROJ + (size_t)r * PROJ_P;
#pragma unroll
            for (int it = 2; it < 3; ++it) wv[rr][it] = *(const u32x4*)(pr + (4 * it + sg) * HD + d0);
            if (r >= M_CTX) { const float* rp = RP + (size_t)((r - M_CTX) % S_LAT) * 128 + rpo; rc[rr][0] = *(const f32x4*)rp; rc[rr][1] = *(const f32x4*)(rp + 4); rs[rr][0] = *(const f32x4*)(rp + 32); rs[rr][1] = *(const f32x4*)(rp + 36); }
            else { rc[rr][0] = rc[rr][1] = (f32x4){1.f, 1.f, 1.f, 1.f}; rs[rr][0] = rs[rr][1] = (f32x4){0.f, 0.f, 0.f, 0.f}; } }
#pragma unroll
        for (int rr = 0; rr < RB; ++rr) { const int r = row + rr; bf16_t* pr = PROJ + (size_t)r * PROJ_P;
            const bool lat = r >= M_CTX;
            int b, t; if (!lat) { b = r / S_CTX; t = r % S_CTX; } else { b = (r - M_CTX) / S_LAT; t = (r - M_CTX) % S_LAT; }
            bf16_t* kdst = lat ? (bf16_t*)(ws + WS_KL) + ((size_t)(l * NB_LAT + b) * S_KVL + PAST + t) * KVW : (bf16_t*)(ws + WS_KC) + (size_t)r * KVW;
            bf16_t* vdst = lat ? (bf16_t*)(ws + WS_VL) + ((size_t)(l * NB_LAT + b) * S_KVL + PAST + t) * KVW : (bf16_t*)(ws + WS_VC) + (size_t)r * KVW;
            float* ckout = out + OUT_CK + (((size_t)b * DEPTH + l) * S_CTX + t) * KVW;
            float* cvout = out + OUT_CV + (((size_t)b * DEPTH + l) * S_CTX + t) * KVW;
#pragma unroll
            for (int it = 2; it < 3; ++it) {
                const int slot = 4 * it + sg;
                const u32x4 w = wv[rr][it];
                float x[8] = {bflo(w.x), bfhi(w.x), bflo(w.y), bfhi(w.y), bflo(w.z), bfhi(w.z), bflo(w.w), bfhi(w.w)};
                if (it == 2 && sg >= 2) {
                    if (!dry) *(u32x4*)(vdst + (slot - 10) * HD + d0) = w;
                    if (!lat && !dry) { *(f32x4*)(cvout + (slot - 10) * HD + d0) = (f32x4){x[0], x[1], x[2], x[3]}; *(f32x4*)(cvout + (slot - 10) * HD + d0 + 4) = (f32x4){x[4], x[5], x[6], x[7]}; }
                }
                float ss = 0.f;
#pragma unroll
                for (int e = 0; e < 8; ++e) ss += x[e] * x[e];
                ss += __shfl_xor(ss, 1); ss += __shfl_xor(ss, 2); ss += __shfl_xor(ss, 4); ss += __shfl_xor(ss, 8);
                const float rstd = 1.0f / sqrtf(ss * (1.0f / HD) + EPS);
                const bool isk = (it == 2);
                float y[8], z[8];
#pragma unroll
                for (int e = 0; e < 8; ++e) y[e] = x[e] * rstd * (isk ? gk[e >> 2][e & 3] : gq[e >> 2][e & 3]);
#pragma unroll
                for (int e = 0; e < 8; ++e) { const float p = __shfl_xor(y[e], 4); z[e] = y[e] * rc[rr][e >> 2][e & 3] + sgn * p * rs[rr][e >> 2][e & 3]; }
                u32x4 o; o.x = cvt_pk_bf16(z[0], z[1]); o.y = cvt_pk_bf16(z[2], z[3]); o.z = cvt_pk_bf16(z[4], z[5]); o.w = cvt_pk_bf16(z[6], z[7]);
                if (dry) { if (o.x == 0x12345678u && o.y == 0x9abcdef0u) *(u32x4*)(pr + slot * HD + d0) = o; }
                else if (it < 2) *(u32x4*)(pr + slot * HD + d0) = o;
                else if (sg < 2) { *(u32x4*)(kdst + (slot - 8) * HD + d0) = o;
                    if (!lat) { *(f32x4*)(ckout + (slot - 8) * HD + d0) = (f32x4){y[0], y[1], y[2], y[3]}; *(f32x4*)(ckout + (slot - 8) * HD + d0 + 4) = (f32x4){y[4], y[5], y[6], y[7]}; } }
            }
        }
    }
}

__device__ __forceinline__ int dequeue(gu32* head, volatile LAS unsigned* slot, int tid) {
    __syncthreads();
    if (tid == 0) *slot = __hip_atomic_fetch_add((unsigned*)head, 1u, __ATOMIC_RELAXED, __HIP_MEMORY_SCOPE_AGENT);
    __syncthreads();
    return (int)*slot;
}

__device__ __forceinline__ void phase_attn(KArgsP a, int l, char* lds, gu32* head, volatile LAS unsigned* slot, int mode, int max_units) {
    const int tid = tid_fresh();
    unsigned char* ws = a->ws;
    const bf16_t* PROJ = (const bf16_t*)(ws + WS_PROJ); bf16_t* MIXA = (bf16_t*)(ws + WS_MIXA);
    const float* qnl = a->q_norm + l * HD;
    constexpr int N_LATU = NB_LAT * NQH * (S_LAT / 256), N_CTXU = NB_CTX * NQH;
    for (int nu = 0; nu < max_units; ++nu) {
        const int it = dequeue(head, slot, tid);
        if (it >= (mode == 0 ? N_LATU : N_CTXU)) break;
        int row0, h, seq; const bf16_t* kb; const bf16_t* vb;
        const float* rope0 = nullptr;
        if (mode == 0) { const int b = it / (NQH * 4), qb = it % 4; h = (it / 4) % NQH; row0 = M_CTX + b * S_LAT + qb * 256; seq = S_KVL; rope0 = (const float*)(ws + WS_ROPE) + (size_t)(qb * 256) * 128;
            kb = (const bf16_t*)(ws + WS_KL) + (size_t)(l * NB_LAT + b) * S_KVL * KVW + (h >> 2) * HD; vb = (const bf16_t*)(ws + WS_VL) + (size_t)(l * NB_LAT + b) * S_KVL * KVW + (h >> 2) * HD; }
        else { const int b = it / NQH; h = it % NQH; row0 = b * S_CTX; seq = S_CTX;
            kb = (const bf16_t*)(ws + WS_KC) + (size_t)row0 * KVW + (h >> 2) * HD; vb = (const bf16_t*)(ws + WS_VC) + (size_t)row0 * KVW + (h >> 2) * HD; }
        att::attn_dense_body(PROJ + (size_t)row0 * PROJ_P + C_Q + h * HD, kb, vb, MIXA + (size_t)row0 * DM + h * HD, seq, PROJ_P, KVW, DM, lds, qnl, rope0);
    }
}

constexpr int GL_QT = 0, GL_KT = 9216, GL_KH = 18432, GL_PP = 46080, GL_ST = 55296, GL_TOT = 73728, GL_RR = 75776, GL_DL = 79872, GL_VT = 81920  , GL_LD = 72;
__device__ __forceinline__ int crow16(int r, int hi) { return (r & 3) + 8 * (r >> 2) + 4 * hi; }
__device__ __forceinline__ unsigned short bf1(float x) { return (unsigned short)(cvt_pk_bf16(x, x) & 0xffffu); }
constexpr int N_GLA_LAT = NB_LAT * GH * 2, N_GLA_CTX = NB_CTX * GH * 2;
__device__ __forceinline__ void phase_gla(KArgsP a, int l, LAS unsigned char* lds, gu32* head, volatile LAS unsigned* slot, int mode, int G) {
    const int tid = tid_fresh(), lane = tid & 63, wave = __builtin_amdgcn_readfirstlane(tid >> 6);
    unsigned char* ws = a->ws;
    const bf16_t* PROJ = (const bf16_t*)(ws + WS_PROJ);
    LAS bf16_t* QT = (LAS bf16_t*)(lds + GL_QT); LAS bf16_t* KT = (LAS bf16_t*)(lds + GL_KT); LAS bf16_t* KH = (LAS bf16_t*)(lds + GL_KH);
    LAS bf16_t* VT = (LAS bf16_t*)(lds + GL_VT); LAS bf16_t* PP = (LAS bf16_t*)(lds + GL_PP); LAS bf16_t* ST = (LAS bf16_t*)(lds + GL_ST);
    LAS float* TOT = (LAS float*)(lds + GL_TOT); LAS float* RR = (LAS float*)(lds + GL_RR); LAS float* DL = (LAS float*)(lds + GL_DL);
    const int r32 = lane & 31, hi = lane >> 5;
    const int ste = wave >> 1, std_ = wave & 1;
    const int oti = wave >> 2, ote = wave & 3;
    int first = (mode == 0) ? (int)blockIdx.x : -1;
    int it_next = (mode == 1) ? N_GLA_LAT + dequeue(head, slot, tid) : 0;
    bool pre = false;
    float wgn[GRANK], bgn = 0.f;
    unsigned pr_r0, pr_v0[8], pr_r1, pr_v1[8], pr_q0[8], pr_k0[8], pr_q1[8], pr_k1[8];
    float qv[8], kv[8];
    const int gi_r = tid >> 3, qksh = 16 * (lane & 1);
    for (;;) {
        int it;
        if (mode == 0) { if (first < 0 || first >= N_GLA_LAT) break; it = first; first += G; }
        else { it = it_next; if (it >= N_GLA_LAT + N_GLA_CTX) break; }
        __syncthreads();
        unsigned nxt_v = 0u;
        if (mode == 1 && tid == 0) nxt_v = __hip_atomic_fetch_add((unsigned*)head, 1u, __ATOMIC_RELAXED, __HIP_MEMORY_SCOPE_AGENT);
        const bool lat = it < N_GLA_LAT; const int u = lat ? it : it - N_GLA_LAT;
        const int dir = u & 1, h = (u >> 1) % GH, b = u / (2 * GH);
        const int T = lat ? S_LAT : S_CTX, row_base = lat ? M_CTX + b * S_LAT : b * S_CTX, nch = T / 64;
        const __amdgpu_buffer_rsrc_t orsrc = __builtin_amdgcn_make_buffer_rsrc((void*)(ws + (dir ? WS_OB : WS_OF)), 0, (int)((size_t)M * 1024 * 2), 0x00020000);
        if (!pre) { const float* wgp = (dir ? a->wg_b : a->wg_f) + (size_t)l * GRANK * 512 + h * GDK + lane;
#pragma unroll
            for (int r = 0; r < GRANK; ++r) wgn[r] = wgp[r * 512];
            bgn = (dir ? a->bg_b : a->bg_f)[l * 512 + h * GDK + lane]; }
        s16x4 whi[GRANK / 4], wlo[GRANK / 4];
#pragma unroll
        for (int kk = 0; kk < GRANK / 4; ++kk) { float wv[4], wl[4]; u32x2 ph, pl;
#pragma unroll
            for (int q = 0; q < 4; ++q) wv[q] = wgn[4 * kk + q];
            ph.x = cvt_pk_bf16(wv[0], wv[1]); ph.y = cvt_pk_bf16(wv[2], wv[3]);
            wl[0] = wv[0] - bflo(ph.x); wl[1] = wv[1] - bfhi(ph.x); wl[2] = wv[2] - bflo(ph.y); wl[3] = wv[3] - bfhi(ph.y);
            pl.x = cvt_pk_bf16(wl[0], wl[1]); pl.y = cvt_pk_bf16(wl[2], wl[3]);
            whi[kk] = __builtin_bit_cast(s16x4, ph); wlo[kk] = __builtin_bit_cast(s16x4, pl); }
        const float bg = bgn;
        f32x16 sacc;
        if (lat) { const float* sp = (dir ? a->st_b : a->st_f) + (((size_t)b * DEPTH + l) * GH + h) * GDK * GDV + (size_t)(32 * std_ + 4 * hi) * GDV + 32 * ste + r32;
#pragma unroll
            for (int r = 0; r < 16; ++r) sacc[r] = sp[(size_t)((r & 3) + 8 * (r >> 2)) * GDV]; }
        else {
#pragma unroll
            for (int r = 0; r < 16; ++r) sacc[r] = 0.f; }
#pragma unroll
        for (int q = 0; q < 4; ++q) { u32x2 w; w.x = cvt_pk_bf16(sacc[4 * q], sacc[4 * q + 1]); w.y = cvt_pk_bf16(sacc[4 * q + 2], sacc[4 * q + 3]);
            *(LAS u32x2*)(ST + (32 * ste + r32) * GL_LD + 32 * std_ + 8 * q + 4 * hi) = w; }
        const __amdgpu_buffer_rsrc_t prsrc = __builtin_amdgcn_make_buffer_rsrc((void*)PROJ, 0, (int)((size_t)M * PROJ_P * 2), 0x00020000);
        const int voff_r = (dir ? 63 - gi_r : gi_r) * (PROJ_P * 2) + ((dir ? C_RB : C_RF) + (tid & 7) * 2) * 2;
        const int voff_v = (C_QG + h * 256 + 128 + 2 * lane) * 2, voff_q = (C_QG + h * 256 + (lane & ~1)) * 2, voff_k = (C_QG + h * 256 + 64 + (lane & ~1)) * 2;
#define GLA_LOADS(S_, c_, rb_, dir_, T_, vr_, vv_, vq_, vk_) do { const int low_ = (rb_) + ((dir_) ? ((T_) - 64 - 64 * (c_)) : 64 * (c_)); \
            pr_r##S_ = __builtin_amdgcn_raw_buffer_load_b32(prsrc, (vr_), low_ * (PROJ_P * 2), 0); \
            _Pragma("unroll") for (int tt = 0; tt < 8; ++tt) { const int so_ = (low_ + ((dir_) ? 63 - (8 * wave + tt) : (8 * wave + tt))) * (PROJ_P * 2); \
                pr_v##S_[tt] = __builtin_amdgcn_raw_buffer_load_b32(prsrc, (vv_), so_, 0); pr_q##S_[tt] = __builtin_amdgcn_raw_buffer_load_b32(prsrc, (vq_), so_, 0); pr_k##S_[tt] = __builtin_amdgcn_raw_buffer_load_b32(prsrc, (vk_), so_, 0); } } while (0)
#define GLA_LOADV(S_, v_) do { if ((v_) < nch) GLA_LOADS(S_, (v_), row_base, dir, T, voff_r, voff_v, voff_q, voff_k); \
            else if (mode == 1) { \
                if ((v_) == nch) { it_next = N_GLA_LAT + (int)*slot; nv = it_next < N_GLA_LAT + N_GLA_CTX;        \
                    if (nv) { const int un = it_next - N_GLA_LAT; dirn = un & 1; hn = (un >> 1) % GH; rbn = (un / (2 * GH)) * S_CTX; \
                        vrn = (dirn ? 63 - gi_r : gi_r) * (PROJ_P * 2) + ((dirn ? C_RB : C_RF) + (tid & 7) * 2) * 2; \
                        vvn = (C_QG + hn * 256 + 128 + 2 * lane) * 2; vqn = (C_QG + hn * 256 + (lane & ~1)) * 2; vkn = (C_QG + hn * 256 + 64 + (lane & ~1)) * 2; } } \
                if (nv) GLA_LOADS(S_, (v_) - nch, rbn, dirn, S_CTX, vrn, vvn, vqn, vkn); } } while (0)
#define GLA_STAGES(S_, par_) do { ((LAS unsigned*)RR)[gi_r * 8 + (tid & 7)] = pr_r##S_; \
            { u32x4 lo, hi4; LAS bf16_t* vt_ = VT + (par_) * (128 * GL_LD); \
              lo.x = __builtin_amdgcn_perm(pr_v##S_[1], pr_v##S_[0], 0x05040100u); lo.y = __builtin_amdgcn_perm(pr_v##S_[3], pr_v##S_[2], 0x05040100u); lo.z = __builtin_amdgcn_perm(pr_v##S_[5], pr_v##S_[4], 0x05040100u); lo.w = __builtin_amdgcn_perm(pr_v##S_[7], pr_v##S_[6], 0x05040100u); \
              hi4.x = __builtin_amdgcn_perm(pr_v##S_[1], pr_v##S_[0], 0x07060302u); hi4.y = __builtin_amdgcn_perm(pr_v##S_[3], pr_v##S_[2], 0x07060302u); hi4.z = __builtin_amdgcn_perm(pr_v##S_[5], pr_v##S_[4], 0x07060302u); hi4.w = __builtin_amdgcn_perm(pr_v##S_[7], pr_v##S_[6], 0x07060302u); \
              *(LAS u32x4*)(vt_ + (2 * lane) * GL_LD + 8 * wave) = lo; *(LAS u32x4*)(vt_ + (2 * lane + 1) * GL_LD + 8 * wave) = hi4; } \
            _Pragma("unroll") for (int tt = 0; tt < 8; ++tt) { qv[tt] = __uint_as_float((pr_q##S_[tt] >> qksh) << 16); kv[tt] = __uint_as_float((pr_k##S_[tt] >> qksh) << 16); } } while (0)
        int dirn = 0, rbn = 0, vrn = 0, vvn = 0, vqn = 0, vkn = 0, hn = 0; bool nv = false;
        if (!pre) { GLA_LOADS(0, 0, row_base, dir, T, voff_r, voff_v, voff_q, voff_k); GLA_STAGES(0, 0);
            GLA_LOADS(1, 1, row_base, dir, T, voff_r, voff_v, voff_q, voff_k); GLA_LOADS(0, 2, row_base, dir, T, voff_r, voff_v, voff_q, voff_k); }
        pre = false;
        for (int c2 = 0; c2 < nch; c2 += 2) {
#pragma unroll
          for (int par = 0; par < 2; ++par) { const int c = c2 + par;
            const int low = row_base + (dir ? (T - 64 - 64 * c) : 64 * c);
            const LAS bf16_t* VTc = VT + par * (128 * GL_LD);
            __syncthreads();
            float bl[8]; float run = 0.f;
            f32x4 zz[2];
#pragma unroll
            for (int g = 0; g < 2; ++g) { const LAS u32x4* rp = (const LAS u32x4*)((const LAS unsigned*)RR + (8 * wave + 4 * g + (lane & 3)) * 8);
                const u32x4 r0 = rp[0], r1 = rp[1];
                const s16x4 a0 = __builtin_bit_cast(s16x4, (u32x2){r0.x, r0.y}), a1 = __builtin_bit_cast(s16x4, (u32x2){r0.z, r0.w}), a2 = __builtin_bit_cast(s16x4, (u32x2){r1.x, r1.y}), a3 = __builtin_bit_cast(s16x4, (u32x2){r1.z, r1.w});
                f32x4 acc = (f32x4){bg, bg, bg, bg};
                acc = __builtin_amdgcn_mfma_f32_4x4x4bf16_1k(a0, whi[0], acc, 0, 0, 0); acc = __builtin_amdgcn_mfma_f32_4x4x4bf16_1k(a1, whi[1], acc, 0, 0, 0);
                acc = __builtin_amdgcn_mfma_f32_4x4x4bf16_1k(a2, whi[2], acc, 0, 0, 0); acc = __builtin_amdgcn_mfma_f32_4x4x4bf16_1k(a3, whi[3], acc, 0, 0, 0);
                acc = __builtin_amdgcn_mfma_f32_4x4x4bf16_1k(a0, wlo[0], acc, 0, 0, 0); acc = __builtin_amdgcn_mfma_f32_4x4x4bf16_1k(a1, wlo[1], acc, 0, 0, 0);
                acc = __builtin_amdgcn_mfma_f32_4x4x4bf16_1k(a2, wlo[2], acc, 0, 0, 0); acc = __builtin_amdgcn_mfma_f32_4x4x4bf16_1k(a3, wlo[3], acc, 0, 0, 0);
                zz[g] = acc; }
#pragma unroll
            for (int tt = 0; tt < 8; ++tt) {
                const float z = zz[tt >> 2][tt & 3];
                const float l2 = __builtin_amdgcn_logf(1.0f + __builtin_amdgcn_exp2f(-1.4426950408889634f * fabsf(z)));
                run += fminf(z, 0.f) * (1.4426950408889634f / 16.0f) - l2 * (1.0f / 16.0f); bl[tt] = run; }
            TOT[wave * 64 + lane] = run;
            __syncthreads();
            float pre = 0.f, blast = 0.f;
#pragma unroll
            for (int w2 = 0; w2 < 8; ++w2) { const float tv = TOT[w2 * 64 + lane]; blast += tv; if (w2 < wave) pre += tv; }
            float kh[8];
            const float eblast = __builtin_amdgcn_exp2f(blast);
#pragma unroll
            for (int tt = 0; tt < 8; ++tt) { const int i = 8 * wave + tt; const float eb = __builtin_amdgcn_exp2f(pre + bl[tt]), kd = kv[tt] * __builtin_amdgcn_rcpf(eb);
                QT[i * GL_LD + lane] = bf1(qv[tt] * 0.125f * eb);
                KT[i * GL_LD + lane] = bf1(kd);
                kh[tt] = kd * eblast; }
            { u32x4 w; w.x = cvt_pk_bf16(kh[0], kh[1]); w.y = cvt_pk_bf16(kh[2], kh[3]); w.z = cvt_pk_bf16(kh[4], kh[5]); w.w = cvt_pk_bf16(kh[6], kh[7]);
              *(LAS u32x4*)(KH + lane * GL_LD + 8 * wave) = w; }
            if (wave == 0) DL[lane] = eblast;
            __syncthreads();
            f32x16 oacc;
#pragma unroll
            for (int r = 0; r < 16; ++r) oacc[r] = 0.f;
#pragma unroll
            for (int ks = 0; ks < 4; ++ks) { const bf16x8 af = *(const LAS bf16x8*)(QT + (32 * oti + r32) * GL_LD + 16 * ks + 8 * hi);
                const bf16x8 bfr = *(const LAS bf16x8*)(ST + (32 * ote + r32) * GL_LD + 16 * ks + 8 * hi);
                oacc = __builtin_amdgcn_mfma_f32_32x32x16_bf16(bfr, af, oacc, 0, 0, 0); }
            if (wave < 4) { const int si = wave >> 1, sj = wave & 1;
                f32x16 p;
#pragma unroll
                for (int r = 0; r < 16; ++r) p[r] = 0.f;
                if (wave != 1) {
#pragma unroll
                    for (int ks = 0; ks < 4; ++ks) { const bf16x8 af = *(const LAS bf16x8*)(QT + (32 * si + r32) * GL_LD + 16 * ks + 8 * hi);
                        const bf16x8 bfr = *(const LAS bf16x8*)(KT + (32 * sj + r32) * GL_LD + 16 * ks + 8 * hi);
                        p = __builtin_amdgcn_mfma_f32_32x32x16_bf16(bfr, af, p, 0, 0, 0); } }
#pragma unroll
                for (int q = 0; q < 4; ++q) { const int i = 32 * si + r32, j0 = 32 * sj + 8 * q + 4 * hi; u32x2 w;
                    w.x = cvt_pk_bf16(j0 <= i ? p[4 * q] : 0.f, j0 + 1 <= i ? p[4 * q + 1] : 0.f); w.y = cvt_pk_bf16(j0 + 2 <= i ? p[4 * q + 2] : 0.f, j0 + 3 <= i ? p[4 * q + 3] : 0.f);
                    *(LAS u32x2*)(PP + i * GL_LD + j0) = w; } }
            __syncthreads();
#pragma unroll
            for (int ks = 0; ks < 4; ++ks) { const bf16x8 af = *(const LAS bf16x8*)(PP + (32 * oti + r32) * GL_LD + 16 * ks + 8 * hi);
                const bf16x8 bfr = *(const LAS bf16x8*)(VTc + (32 * ote + r32) * GL_LD + 16 * ks + 8 * hi);
                oacc = __builtin_amdgcn_mfma_f32_32x32x16_bf16(bfr, af, oacc, 0, 0, 0); }
#pragma unroll
            for (int q = 0; q < 4; ++q) { const int i = 32 * oti + r32; u32x2 w; w.x = cvt_pk_bf16(oacc[4 * q], oacc[4 * q + 1]); w.y = cvt_pk_bf16(oacc[4 * q + 2], oacc[4 * q + 3]);
                __builtin_amdgcn_raw_buffer_store_b64(w, orsrc, (dir ? 63 - i : i) * 2048 + (h * GDV + 32 * ote + 8 * q + 4 * hi) * 2, low * 2048, 0); }
#pragma unroll
            for (int q = 0; q < 4; ++q) { const f32x4 dl = *(const LAS f32x4*)(DL + 32 * std_ + 8 * q + 4 * hi);
                sacc[4 * q] *= dl[0]; sacc[4 * q + 1] *= dl[1]; sacc[4 * q + 2] *= dl[2]; sacc[4 * q + 3] *= dl[3]; }
#pragma unroll
            for (int ks = 0; ks < 4; ++ks) { const bf16x8 af = *(const LAS bf16x8*)(VTc + (32 * ste + r32) * GL_LD + 16 * ks + 8 * hi);
                const bf16x8 bfr = *(const LAS bf16x8*)(KH + (32 * std_ + r32) * GL_LD + 16 * ks + 8 * hi);
                sacc = __builtin_amdgcn_mfma_f32_32x32x16_bf16(bfr, af, sacc, 0, 0, 0); }
#pragma unroll
            for (int q = 0; q < 4; ++q) { u32x2 w; w.x = cvt_pk_bf16(sacc[4 * q], sacc[4 * q + 1]); w.y = cvt_pk_bf16(sacc[4 * q + 2], sacc[4 * q + 3]);
                *(LAS u32x2*)(ST + (32 * ste + r32) * GL_LD + 32 * std_ + 8 * q + 4 * hi) = w; }
            if (c + 1 < nch || (mode == 1 && nv)) {
                if (par == 0) GLA_STAGES(1, 1); else GLA_STAGES(0, 0);
                if (c + 1 == nch) { const float* wgp = (dirn ? a->wg_b : a->wg_f) + (size_t)l * GRANK * 512 + hn * GDK + lane;
#pragma unroll
                    for (int r = 0; r < GRANK; ++r) wgn[r] = wgp[r * 512];
                    bgn = (dirn ? a->bg_b : a->bg_f)[l * 512 + hn * GDK + lane];
                    pre = true; } }
            if (par == 0) GLA_LOADV(1, c + 3); else GLA_LOADV(0, c + 3);
            if (c == 0 && mode == 1 && tid == 0) *slot = nxt_v;
          }
        }
#undef GLA_LOADS
#undef GLA_LOADV
#undef GLA_STAGES
        if (!lat) { float* so = a->out + (dir ? OUT_SB : OUT_SF) + (((size_t)b * DEPTH + l) * GH + h) * GDK * GDV + (size_t)(32 * std_ + 4 * hi) * GDV + 32 * ste + r32;
#pragma unroll
            for (int r = 0; r < 16; ++r) so[(size_t)((r & 3) + 8 * (r >> 2)) * GDV] = sacc[r]; }
    }
}

__device__ __forceinline__ void phase_glafin(KArgsP a, int l, int G) {
    const int tid = tid_fresh(), lane = tid & 63, wave = __builtin_amdgcn_readfirstlane(tid >> 6);
    unsigned char* ws = a->ws;
    const bf16_t* OF = (const bf16_t*)(ws + WS_OF); const bf16_t* OB = (const bf16_t*)(ws + WS_OB);
    const bf16_t* PROJ = (const bf16_t*)(ws + WS_PROJ); bf16_t* MIXA = (bf16_t*)(ws + WS_MIXA);
    const int gw = blockIdx.x * 8 + wave, NGW = G * 8;
    constexpr int RB = 3;
    f32x4 gn[2]; { const float* gp = a->gla_norm + l * GDV + ((8 * lane) & 127); gn[0] = *(const f32x4*)gp; gn[1] = *(const f32x4*)(gp + 4); }
    for (int row = gw * RB; row < M; row += NGW * RB) {
        u32x4 wf[RB][2], wb[RB][2], wo[RB][2];
#pragma unroll
        for (int rr = 0; rr < RB; ++rr)
#pragma unroll
            for (int j = 0; j < 2; ++j) { const int c = 512 * j + 8 * lane; const size_t r = row + rr;
                wf[rr][j] = __builtin_nontemporal_load((const u32x4*)(OF + r * 1024 + c)); wb[rr][j] = __builtin_nontemporal_load((const u32x4*)(OB + r * 1024 + c)); wo[rr][j] = __builtin_nontemporal_load((const u32x4*)(PROJ + r * PROJ_P + C_OG + c)); }
#pragma unroll
        for (int rr = 0; rr < RB; ++rr)
#pragma unroll
            for (int j = 0; j < 2; ++j) { const u32x4 f = wf[rr][j], b = wb[rr][j], g = wo[rr][j];
                float o[8] = {bflo(f.x) + bflo(b.x), bfhi(f.x) + bfhi(b.x), bflo(f.y) + bflo(b.y), bfhi(f.y) + bfhi(b.y), bflo(f.z) + bflo(b.z), bfhi(f.z) + bfhi(b.z), bflo(f.w) + bflo(b.w), bfhi(f.w) + bfhi(b.w)};
                const float og[8] = {bflo(g.x), bfhi(g.x), bflo(g.y), bfhi(g.y), bflo(g.z), bfhi(g.z), bflo(g.w), bfhi(g.w)};
                float ss = 0.f;
#pragma unroll
                for (int e = 0; e < 8; ++e) ss += o[e] * o[e];
                ss += __shfl_xor(ss, 1); ss += __shfl_xor(ss, 2); ss += __shfl_xor(ss, 4); ss += __shfl_xor(ss, 8);
                const float rstd = 1.0f / sqrtf(ss * (1.0f / GDV) + EPS);
                float y[8];
#pragma unroll
                for (int e = 0; e < 8; ++e) y[e] = o[e] * rstd * gn[e >> 2][e & 3] * silu_f(og[e]);
                u32x4 w; w.x = cvt_pk_bf16(y[0], y[1]); w.y = cvt_pk_bf16(y[2], y[3]); w.z = cvt_pk_bf16(y[4], y[5]); w.w = cvt_pk_bf16(y[6], y[7]);
                *(u32x4*)(MIXA + (size_t)(row + rr) * DM + 1024 + 512 * j + 8 * lane) = w; }
    }
}

constexpr int PH_PER_LAYER = 9, N_PHASES = 2 + DEPTH * PH_PER_LAYER;
__global__ void __launch_bounds__(512, 2) hybrid_fwd(Args args) {
    extern __shared__ __attribute__((aligned(16))) unsigned char lds_raw[];
    LAS unsigned char* lds = (LAS unsigned char*)lds_raw;
    volatile LAS unsigned* MISC = (volatile LAS unsigned*)(lds + MISC_OFF);
    const int tid = threadIdx.x, G = gridDim.x;
    KArgsP ka0 = ka_get();
    unsigned char* ws = ka0->ws;
    gu32* ctl = (gu32*)(ws + WS_CTL);
    for (int u = tid; u < (LDS_BYTES - RING_BYTES) / 4; u += 512) ((LAS unsigned*)(lds + RING_BYTES))[u] = 0u;
    __syncthreads();
#if MK_PER_PHASE
#define GRID_BAR() do { } while (0)
#else
    XcdBarrier bar = xcd_barrier_post((unsigned*)(ctl + CW_BAR), MISC + 8);
#define GRID_BAR() xcd_barrier(bar)
#endif
    const int lo = ka0->ph_lo, hi = ka0->ph_hi;
#define IN(k) (lo <= (k) && (k) < hi)
#ifndef MK_DUPBAR
#define MK_DUPBAR 0
#endif
#define SEAM(k) do { if (IN(k) && IN((k) + 1)) { GRID_BAR(); if (MK_DUPBAR) GRID_BAR(); } } while (0)
    bf16_t* XB = (bf16_t*)(ws + WS_XB);
    const float* MOD = (const float*)(ws + WS_MOD);
    bf16_t* H = (bf16_t*)(ws + WS_H); bf16_t* PROJ = (bf16_t*)(ws + WS_PROJ); bf16_t* MIXA = (bf16_t*)(ws + WS_MIXA); bf16_t* HID = (bf16_t*)(ws + WS_HID);

    if (HAS(0) && IN(0)) { for (int rep = 0; rep < DUP(0); ++rep) { if (MK_DUPSYNC && rep) GRID_BAR(); phase_prologue(ka_get(), lds, G); __syncthreads(); } } SEAM(0);

    for (int l = 0; l < DEPTH; ++l) {
        const int p0 = 1 + l * PH_PER_LAYER;
        const float* mod_l = MOD + (size_t)l * NGRP * (6 * DM);

        if (HAS(1) && IN(p0 + 0)) for (int rep = 0; rep < DUP(1); ++rep) { if (MK_DUPSYNC && rep) GRID_BAR();
            phase_norm(XB, (l == 0 || rep) ? nullptr : (const bf16_t*)(ws + WS_SIDE), ka_get()->norm1 + l * DM, mod_l, 0 * DM, 1 * DM, H, G, l == 0 && rep == 0); } SEAM(p0 + 0);
        for (int sub = 0; sub < 2; ++sub) {
            if (HAS(2) && IN(p0 + 1 + sub)) for (int rep = 0; rep < DUP(10 + sub); ++rep) { if (MK_DUPSYNC && rep) GRID_BAR(); constexpr int NU = (M / 256) * (PROJ_P / 256), NA3 = 3 * 256;
                pg8::Gemm g{H, (const bf16_t*)(ws + WS_WIN) + (size_t)l * PROJ_P * DM, M, PROJ_P, DM}; pg8::InOrder S; S.init(G, (int)blockIdx.x, sub ? NA3 : 0, sub ? NU : NA3);
                KArgsP ka = ka_get(); pg8::EpiIn E{PROJ, ws, ka->out, ka->k_norm + l * HD, (LAS float*)(lds + RING_BYTES + 2048), l}; pg8::gemm_phase<pg8::EpiIn, pg8::InOrder, true, true>(lds, g, S, E);
                if (sub == 1 && HAS(4) && NA3 + (int)blockIdx.x >= NU) { __syncthreads(); phase_attn(ka_get(), l, (char*)lds_raw, ctl + CW_Q + 64 * (3 * l), MISC + 16, 0, 1); __syncthreads(); } }
            SEAM(p0 + 1 + sub); }


        if (IN(p0 + 3)) for (int rep = 0; rep < ((DUP(4) == 2 || DUP(5) == 2) ? 2 : 1); ++rep) { if (MK_DUPSYNC && rep) GRID_BAR();
            for (int pass = 0; pass < 2; ++pass) {
                if (HAS(5)) { phase_gla(ka_get(), l, lds, ctl + CW_Q + 64 * (3 * l + 1 + 16 * rep), MISC + 17, pass, G); __syncthreads(); }
                if (MK_PROBE_GLALAT && pass == 0) { GRID_BAR(); phase_gla(ka_get(), l, lds, ctl + CW_Q + 64 * (3 * l + 1 + 16 * rep), MISC + 17, 0, G); __syncthreads(); GRID_BAR(); }
                if (HAS(4)) { phase_attn(ka_get(), l, (char*)lds_raw, ctl + CW_Q + 64 * (3 * l + 2 * pass + 16 * rep), MISC + 16, pass, 1 << 30); __syncthreads(); } } } SEAM(p0 + 3);
        if (HAS(6) && IN(p0 + 4)) for (int rep = 0; rep < DUP(6); ++rep) { if (MK_DUPSYNC && rep) GRID_BAR(); phase_glafin(ka_get(), l, G); } SEAM(p0 + 4);
        if (HAS(7) && IN(p0 + 5)) for (int rep = 0; rep < DUP(7); ++rep) { if (MK_DUPSYNC && rep) GRID_BAR(); pg8::Gemm g{MIXA, (const bf16_t*)(ws + WS_WOUT) + (size_t)l * DM * DM, M, DM, DM}; pg8::SplitLatOrder S; S.init(DM, G, (int)blockIdx.x, WG_SPL);
            pg8::EpiResid E{XB, mod_l + 2 * DM, (bf16_t*)(ws + WS_SIDE), (DUP(7) == 2 && rep == 0) ? (lo >= 0) : 0}; pg8::gemm_phase<pg8::EpiResid, pg8::SplitLatOrder, true, true>(lds, g, S, E); } SEAM(p0 + 5);
        if (HAS(1) && IN(p0 + 6)) for (int rep = 0; rep < DUP(1); ++rep) { if (MK_DUPSYNC && rep) GRID_BAR(); phase_norm(XB, rep ? nullptr : (const bf16_t*)(ws + WS_SIDE), ka_get()->norm2 + l * DM, mod_l, 3 * DM, 4 * DM, H, G); } SEAM(p0 + 6);
        if (HAS(8) && IN(p0 + 7)) for (int rep = 0; rep < DUP(8); ++rep) { if (MK_DUPSYNC && rep) GRID_BAR(); pg8::Gemm g{H, (const bf16_t*)(ws + WS_WUP) + (size_t)l * DFF * DM, M, DFF, DM}; pg8::StaticOrder S; S.init(M, DFF, G, (int)blockIdx.x, DM, WG_UP);
            pg8::EpiBf16<1> E{HID, DFF}; pg8::gemm_phase<pg8::EpiBf16<1>, pg8::StaticOrder, true, true>(lds, g, S, E); } SEAM(p0 + 7);
        if (HAS(9) && IN(p0 + 8)) for (int rep = 0; rep < DUP(9); ++rep) { if (MK_DUPSYNC && rep) GRID_BAR(); pg8::Gemm g{HID, (const bf16_t*)(ws + WS_WDN) + (size_t)l * DM * DFF, M, DM, DFF}; pg8::SplitLatOrder S; S.init(DFF, G, (int)blockIdx.x, WG_SPL);
            pg8::EpiResid E{XB, mod_l + 5 * DM, (bf16_t*)(ws + WS_SIDE), (DUP(9) == 2 && rep == 0) ? (lo >= 0) : ((l == DEPTH - 1) ? 2 : 0)}; pg8::gemm_phase<pg8::EpiResid, pg8::SplitLatOrder, true, true>(lds, g, S, E); } SEAM(p0 + 8);
    }
    if (IN(N_PHASES - 1)) { const int t2 = tid_fresh(); float* Y = ka_get()->out + OUT_Y; const bf16_t* sd = (const bf16_t*)(ws + WS_SIDE);
        for (size_t i = (size_t)M_CTX * DM / 8 + (size_t)blockIdx.x * 512 + t2; i < (size_t)M * DM / 8; i += (size_t)G * 512) { const u32x4 w = __builtin_nontemporal_load((const u32x4*)(XB + i * 8));
            f32x4 a = (f32x4){bflo(w.x), bfhi(w.x), bflo(w.y), bfhi(w.y)}, b = (f32x4){bflo(w.z), bfhi(w.z), bflo(w.w), bfhi(w.w)};
            if (i >= (size_t)M_CTX * DM / 8) { const u32x4 v = __builtin_nontemporal_load((const u32x4*)(sd + (i - (size_t)M_CTX * DM / 8) * 8));
                a += (f32x4){bflo(v.x), bfhi(v.x), bflo(v.y), bfhi(v.y)}; b += (f32x4){bflo(v.z), bfhi(v.z), bflo(v.w), bfhi(v.w)}; }
            __builtin_nontemporal_store(a, (f32x4*)(Y + i * 8)); __builtin_nontemporal_store(b, (f32x4*)(Y + i * 8 + 4)); } }
#undef IN
#undef SEAM
}

extern "C" void kernel_launch(void* const* d_in, const int* in_sizes, int n_in, void* d_out, int out_size, void* d_ws, size_t ws_size, hipStream_t stream) {
    static int grid = 0;
    if (grid == 0) {
        if (n_in != 23 || (size_t)out_size != OUT_END || ws_size < WS_END) { fprintf(stderr, "kernel_launch: unexpected shapes (n_in %d out %d ws %zu)\n", n_in, out_size, ws_size); grid = -1; return; }
        int dev = 0, cus = 0, per_cu = 0;
        if (hipGetDevice(&dev) != hipSuccess || hipDeviceGetAttribute(&cus, hipDeviceAttributeMultiprocessorCount, dev) != hipSuccess) { grid = -1; return; }
        if (hipFuncSetAttribute((const void*)hybrid_fwd, hipFuncAttributeMaxDynamicSharedMemorySize, LDS_BYTES) != hipSuccess) { fprintf(stderr, "kernel_launch: hipFuncSetAttribute failed\n"); grid = -1; return; }
        if (hipOccupancyMaxActiveBlocksPerMultiprocessor(&per_cu, (const void*)hybrid_fwd, 512, LDS_BYTES) != hipSuccess || per_cu < 1) { fprintf(stderr, "kernel_launch: occupancy query says %d\n", per_cu); }
        (void)hipGetLastError();
        grid = cus;
    }
    if (grid < 0) return;
    if (hipMemsetAsync((char*)d_ws + WS_CTL, 0, CTL_ZERO_BYTES, stream) != hipSuccess) return;
    Args a{};
    a.x_prompt = (const float*)d_in[0]; a.x_sample = (const float*)d_in[1]; a.cache_k = (const float*)d_in[2]; a.cache_v = (const float*)d_in[3];
    a.st_f = (const float*)d_in[4]; a.st_b = (const float*)d_in[5]; a.c = (const float*)d_in[6]; a.c_ctx = (const float*)d_in[7];
    a.w_mod = (const float*)d_in[8]; a.b_mod = (const float*)d_in[9]; a.norm1 = (const float*)d_in[10]; a.w_in = (const float*)d_in[11];
    a.q_norm = (const float*)d_in[12]; a.k_norm = (const float*)d_in[13]; a.wg_f = (const float*)d_in[14]; a.bg_f = (const float*)d_in[15];
    a.wg_b = (const float*)d_in[16]; a.bg_b = (const float*)d_in[17]; a.gla_norm = (const float*)d_in[18]; a.w_out = (const float*)d_in[19];
    a.norm2 = (const float*)d_in[20]; a.w_up = (const float*)d_in[21]; a.w_down = (const float*)d_in[22];
    a.out = (float*)d_out; a.ws = (unsigned char*)d_ws;
#if MK_PER_PHASE
    for (int p = 0; p < N_PHASES; ++p) { a.ph_lo = p; a.ph_hi = p + 1; hipLaunchKernelGGL(hybrid_fwd, dim3(grid), dim3(512), LDS_BYTES, stream, a); }
#else
    a.ph_lo = 0; a.ph_hi = N_PHASES;
    hipLaunchKernelGGL(hybrid_fwd, dim3(grid), dim3(512), LDS_BYTES, stream, a);
#endif
    const hipError_t le = hipPeekAtLastError();
    if (le != hipSuccess) fprintf(stderr, "kernel_launch: launch failed: %s\n", hipGetErrorName(le));
}
```

```cpp
#include <hip/hip_runtime.h>
#include <cstdio>
#include <cstdint>

#ifndef MK_PER_PHASE
#define MK_PER_PHASE 0
#endif
#ifndef CONV_TAILS
#define CONV_TAILS 0
#endif
#ifndef WG_IN
#define WG_IN 4
#endif
#ifndef WG_UP
#define WG_UP 8
#endif
#ifndef WG_SPL
#define WG_SPL 4
#endif
#ifndef PRO_NT
#define PRO_NT 1
#endif
#ifndef MK_MASK
#define MK_MASK 0x3ff
#endif
#define HAS(k) ((MK_MASK >> (k)) & 1)
#ifndef MK_DUP
#define MK_DUP 0
#endif
#define DUP(k) (((MK_DUP >> (k)) & 1) ? 2 : 1)
#ifndef MK_PROBE_GLALAT
#define MK_PROBE_GLALAT 0
#endif
#ifndef MK_DUPSYNC
#define MK_DUPSYNC 0
#endif

#define LAS __attribute__((address_space(3)))
#define GAS __attribute__((address_space(1)))
typedef unsigned short bf16_t;
typedef short bf16x8 __attribute__((ext_vector_type(8)));
typedef short s16x4 __attribute__((ext_vector_type(4)));
typedef float f32x2 __attribute__((ext_vector_type(2)));
typedef float f32x4 __attribute__((ext_vector_type(4)));
typedef float f32x16 __attribute__((ext_vector_type(16)));
typedef unsigned u32x2 __attribute__((ext_vector_type(2)));
typedef unsigned u32x4 __attribute__((ext_vector_type(4)));
typedef GAS unsigned gu32;

constexpr int DM = 2048, NB_CTX = 32, S_CTX = 256, DEPTH = 4, NB_LAT = 4, S_LAT = 1024, PAST = 256;
constexpr int M_CTX = NB_CTX * S_CTX, M_LAT = NB_LAT * S_LAT, M = M_CTX + M_LAT;
constexpr int HD = 128, NQH = 8, NKVH = 2, KVW = 256, GH = 8, GDK = 64, GDV = 128, GRANK = 16;
constexpr int DFF = 8192, PROJ_W = 4640, PROJ_P = 4864;
constexpr int C_Q = 0, C_K = 1024, C_V = 1280, C_QG = 1536, C_KG = 2048, C_VG = 2560, C_OG = 3584, C_RF = 4608, C_RB = 4624;
constexpr int NGRP = 1 + NB_LAT;
constexpr int S_KVL = PAST + S_LAT;
constexpr float EPS = 1e-6f;

constexpr size_t MiB = 1u << 20;
constexpr size_t WS_CTL = 0, CTL_ZERO_BYTES = 128 * 1024;
constexpr size_t WS_MOD = 1 * MiB;
constexpr size_t WS_ROPE = 2 * MiB;
constexpr size_t WS_WIN = 4 * MiB;
constexpr size_t WS_WOUT = 80 * MiB;
constexpr size_t WS_WUP = 112 * MiB;
constexpr size_t WS_WDN = 240 * MiB;
constexpr size_t WS_H = 368 * MiB;
constexpr size_t WS_PROJ = 416 * MiB;
constexpr size_t WS_MIXA = 530 * MiB;
constexpr size_t WS_HID = 578 * MiB;
constexpr size_t WS_KC = 770 * MiB, WS_VC = 774 * MiB;
constexpr size_t WS_KL = 778 * MiB, WS_VL = 788 * MiB;
constexpr size_t WS_OF = 798 * MiB, WS_OB = 846 * MiB;
constexpr size_t WS_SIDE = 894 * MiB;
constexpr size_t WS_XB = 912 * MiB;
constexpr size_t WS_END = 960 * MiB;
static_assert(WS_WIN + (size_t)DEPTH * PROJ_P * DM * 2 <= WS_WOUT && WS_PROJ + (size_t)M * PROJ_P * 2 <= WS_MIXA && WS_HID + (size_t)M * DFF * 2 <= WS_KC, "ws map");
static_assert(WS_KL + (size_t)DEPTH * NB_LAT * S_KVL * KVW * 2 <= WS_VL && WS_OF + (size_t)M * 1024 * 4 <= WS_OB, "ws map 2");
constexpr int CW_BAR = 4096;
constexpr int CW_Q = 16384;
constexpr size_t OUT_Y = 0, OUT_CK = (size_t)M * DM, OUT_CV = OUT_CK + (size_t)M_CTX * DEPTH * KVW, OUT_SF = OUT_CV + (size_t)M_CTX * DEPTH * KVW,
                 OUT_SB = OUT_SF + (size_t)NB_CTX * DEPTH * GH * GDK * GDV, OUT_END = OUT_SB + (size_t)NB_CTX * DEPTH * GH * GDK * GDV;

constexpr int RING_BYTES = 131072, MISC_OFF = RING_BYTES + 320, LDS_BYTES = 147456;

typedef __bf16 bf16x2_t __attribute__((ext_vector_type(2)));
typedef short s16x4 __attribute__((ext_vector_type(4)));
__device__ __forceinline__ unsigned cvt_pk_bf16(float lo, float hi) { const f32x2 v = {lo, hi}; const bf16x2_t b = __builtin_convertvector(v, bf16x2_t); return __builtin_bit_cast(unsigned, b); }
__device__ __forceinline__ unsigned f2bf(float f) { unsigned u = __builtin_bit_cast(unsigned, f); return (u + 0x7fffu + ((u >> 16) & 1u)) >> 16; }
__device__ __forceinline__ unsigned pk2(float lo, float hi) { return f2bf(lo) | (f2bf(hi) << 16); }
__device__ __forceinline__ float bf2f(unsigned short b) { return __builtin_bit_cast(float, ((unsigned)b) << 16); }
__device__ __forceinline__ float bflo(unsigned w) { return __builtin_bit_cast(float, w << 16); }
__device__ __forceinline__ float bfhi(unsigned w) { return __builtin_bit_cast(float, w & 0xffff0000u); }
__device__ __forceinline__ int tid_fresh() { int t = threadIdx.x; asm volatile("" : "+v"(t)); return t; }
#define LDS_WAIT() asm volatile("s_waitcnt lgkmcnt(0)" ::: "memory")
#define VM_WAIT() asm volatile("s_waitcnt vmcnt(0)" ::: "memory")

__device__ __forceinline__ float* mk_out_ptr();
namespace pg8 {
constexpr int BM = 256, BK = 64, HALF = 128, HTB = HALF * BK * 2, STAGE_BYTES = 8 * HTB, NXCD = 8;
__host__ __device__ __forceinline__ int lds_byte(int r, int c) { const int st = (r >> 4) * 2 + (c >> 5), rr = r & 15, cc = c & 31, ob = rr * 64 + cc * 2; return st * 1024 + (ob ^ (((ob >> 9) & 1) << 5)); }
__host__ __device__ __forceinline__ void stage_rc(int b, int& R, int& C) { const int st = b / 1024, sb = b % 1024, swz = sb ^ (((sb >> 9) & 1) << 5); R = (st >> 1) * 16 + swz / 64; C = (st & 1) * 32 + (swz % 64) / 2; }
__host__ __device__ __forceinline__ int perm32(int rho) { const int n = rho >> 4, i = rho & 15; return 8 * (i >> 2) + 4 * n + (i & 3); }

struct Unit { int pm, pn, k0, nt, aux; };
struct Gemm { const bf16_t* A; const bf16_t* Bt; int M, N, K; };

struct StaticOrder {
    int nM, nN, nwg, G, c, ntf, WGM;
    __device__ void init(int M_, int N_, int G_, int c_, int K_, int wgm = 4) { nM = M_ / BM; nN = N_ / BM; nwg = nM * nN; G = G_; c = c_; ntf = K_ / BK; WGM = wgm; }
    __device__ void map(int wgid, Unit& u) const {
        { const int q = nwg / NXCD, r = nwg % NXCD, xcd = wgid % NXCD, off = wgid / NXCD; wgid = (xcd < r ? xcd * (q + 1) : r * (q + 1) + (xcd - r) * q) + off; }
        const int nig = WGM * nN, gid = wgid / nig, fm = gid * WGM, gsz = (nM - fm) < WGM ? (nM - fm) : WGM;
        u.pm = fm + ((wgid % nig) % gsz); u.pn = (wgid % nig) / gsz; u.k0 = 0; u.nt = ntf; u.aux = 0;
    }
    __device__ bool next(int i, Unit& u) const { const long L = (long)i * G + c; if (L >= nwg) return false; map((int)L, u); return true; }
    __device__ __forceinline__ void a_ready(const Unit&) const {}
    __device__ __forceinline__ void done(const Unit&) const {}
};
struct InOrder {
    int G, c, base, limit;
    __device__ void init(int G_, int c_, int base_, int limit_) { G = G_; c = c_; base = base_; limit = limit_; }
    __device__ bool next(int i, Unit& u) const {
        const long L = (long)base + (long)i * G + c; if (L >= limit) return false;
        const int xcd = (int)(L % NXCD), off = (int)(L / NXCD);
        if (off >= 58 && off < 96) { const int j = 38 * xcd + (off - 58 + 8) % 38, gid = j / 76, w = j % 76;
            u.pm = M_CTX / BM + 4 * gid + (w & 3); u.pn = w >> 2; }
        else { const int w = off < 58 ? off : off - 38; u.pm = 4 * xcd + (w & 3); u.pn = w >> 2; }
        u.k0 = 0; u.nt = DM / BK; u.aux = 0; return true;
    }
    __device__ __forceinline__ void a_ready(const Unit&) const {}
    __device__ __forceinline__ void done(const Unit&) const {}
};
static_assert((M_LAT / BM) * (PROJ_P / BM) == 8 * 38 && (M_CTX / BM) * (PROJ_P / BM) == 8 * 76, "InOrder: 38 latent + 76 context units per XCD slot");
struct SplitLatOrder {
    StaticOrder sa, sb; int G, c, nth;
    __device__ void init(int K_, int G_, int c_, int wgm = 4) { G = G_; c = c_; nth = K_ / BK / 2; sa.init(M_CTX, DM, G_, c_, K_, wgm); sb.init(M_LAT, 2 * DM, G_, c_, K_, wgm); }
    __device__ bool next(int i, Unit& u) const {
        long L = (long)i * G + c;
        if (G == sa.nwg && G == sb.nwg && (c & 4) && i < 2) L = (long)(1 - i) * G + c;
        if (L < sa.nwg) { sa.map((int)L, u); return true; }
        if (L < sa.nwg + sb.nwg) { sb.map((int)(L - sa.nwg), u); const int kh = u.pn >> 3; u.pn &= 7; u.pm += M_CTX / BM; u.k0 = kh * nth * BK; u.nt = nth; u.aux = kh; return true; }
        return false;
    }
    __device__ __forceinline__ void a_ready(const Unit&) const {}
    __device__ __forceinline__ void done(const Unit&) const {}
};

template <int ACT  > struct EpiBf16 {
    static constexpr bool PERM = true, AFTER_DRAIN = false;
    bf16_t* O; int ldc;
    __device__ __forceinline__ void operator()(const f32x4 (&acc)[2][2][4][2], const Unit& u, int wr, int wc, int fr, int fq) const {
        const int row0 = u.pm * BM + wr * 64 + fr, col0 = u.pn * BM + wc * 32 + 8 * fq;
#pragma unroll
        for (int ai = 0; ai < 2; ++ai)
#pragma unroll
            for (int m = 0; m < 4; ++m) { bf16_t* rowp = O + (size_t)(row0 + ai * HALF + m * 16) * ldc + col0;
#pragma unroll
                for (int bj = 0; bj < 2; ++bj) { f32x4 v0 = acc[ai][bj][m][0], v1 = acc[ai][bj][m][1];
                    if (ACT == 1) {
#pragma unroll
                        for (int j = 0; j < 4; ++j) { const float a = fmaxf(v0[j], 0.f), b = fmaxf(v1[j], 0.f); v0[j] = a * a; v1[j] = b * b; } }
                    u32x4 w; w.x = cvt_pk_bf16(v0[0], v0[1]); w.y = cvt_pk_bf16(v0[2], v0[3]); w.z = cvt_pk_bf16(v1[0], v1[1]); w.w = cvt_pk_bf16(v1[2], v1[3]);
                    *(u32x4*)(rowp + bj * HALF) = w; } }
    }
};
struct EpiIn {
    static constexpr bool PERM = true, AFTER_DRAIN = false;
    bf16_t* O; unsigned char* ws; float* out; const float* kn; LAS float* xl; int l;
    __device__ __forceinline__ void operator()(const f32x4 (&acc)[2][2][4][2], const Unit& u, int wr, int wc, int fr, int fq_) const {
        int fq = fq_;
        int rl0 = wr * 64 + fr;
        asm volatile("" : "+v"(rl0), "+v"(fq));
        const bool lat = u.pm >= M_CTX / BM;
        const int b = lat ? (u.pm - M_CTX / BM) >> 2 : u.pm, t0 = lat ? ((u.pm - M_CTX / BM) & 3) * 256 : 0;
        bf16_t* kvdst = (bf16_t*)(ws + (u.pn == 4 ? (lat ? WS_KL : WS_KC) : (lat ? WS_VL : WS_VC))) + (lat ? ((size_t)(l * NB_LAT + b) * S_KVL + PAST + t0) * KVW : (size_t)u.pm * BM * KVW);
        float* cout = out + (u.pn == 4 ? OUT_CK : OUT_CV) + ((size_t)b * DEPTH + l) * S_CTX * KVW;
        if (u.pn != 4 && u.pn != 5) {
            const bool isv = false;
            bf16_t* dst = isv ? kvdst + wc * 32 + 8 * fq : O + (size_t)u.pm * BM * PROJ_P + u.pn * BM + wc * 32 + 8 * fq;
            const int ld = isv ? KVW : PROJ_P;
            float* co = cout + wc * 32 + 8 * fq;
#pragma unroll
            for (int ai = 0; ai < 2; ++ai)
#pragma unroll
                for (int m = 0; m < 4; ++m) { const int rl = rl0 + ai * HALF + m * 16;
#pragma unroll
                    for (int bj = 0; bj < 2; ++bj) { const f32x4 v0 = acc[ai][bj][m][0], v1 = acc[ai][bj][m][1];
                        u32x4 w; w.x = cvt_pk_bf16(v0[0], v0[1]); w.y = cvt_pk_bf16(v0[2], v0[3]); w.z = cvt_pk_bf16(v1[0], v1[1]); w.w = cvt_pk_bf16(v1[2], v1[3]);
                        *(u32x4*)(dst + rl * ld + bj * HALF) = w;
                        if (isv && !lat) { *(f32x4*)(co + rl * KVW + bj * HALF) = v0; *(f32x4*)(co + rl * KVW + bj * HALF + 4) = v1; } }
                    asm volatile("" ::: "memory"); }
            return;
        }
        const bool isk = u.pn == 4;
        const int g = 4 * wc + fq, base = g < 8 ? 4 * g : 64 + 4 * (g - 8);
        const float* RP = (const float*)(ws + WS_ROPE);
        const int rpo = (g >> 3) * 64 + 4 * (g & 7);
        f32x4 rcv[2][4], rsv[2][4];
#pragma unroll
        for (int ai = 0; ai < 2; ++ai)
#pragma unroll
            for (int m = 0; m < 4; ++m) { rcv[ai][m] = (f32x4){1.f, 1.f, 1.f, 1.f}; rsv[ai][m] = (f32x4){0.f, 0.f, 0.f, 0.f};
                if (lat && isk) { const float* rp = RP + (size_t)(t0 + rl0 + ai * HALF + m * 16) * 128 + rpo; rcv[ai][m] = *(const f32x4*)rp; rsv[ai][m] = *(const f32x4*)(rp + 32); } }
        const f32x4 one4 = (f32x4){1.f, 1.f, 1.f, 1.f};
        const f32x4 gk0 = isk ? *(const f32x4*)(kn + base) : one4, gk1 = isk ? *(const f32x4*)(kn + base + 32) : one4;
        if (isk) {
#pragma unroll
        for (int ai = 0; ai < 2; ++ai)
#pragma unroll
            for (int m = 0; m < 4; ++m)
#pragma unroll
                for (int bj = 0; bj < 2; ++bj) { const f32x4 v0 = acc[ai][bj][m][0], v1 = acc[ai][bj][m][1];
                    float ss = (v0[0] * v0[0] + v0[1] * v0[1]) + (v0[2] * v0[2] + v0[3] * v0[3]) + (v1[0] * v1[0] + v1[1] * v1[1]) + (v1[2] * v1[2] + v1[3] * v1[3]);
                    ss += __shfl_xor(ss, 16); ss += __shfl_xor(ss, 32);
                    if (fq == 0) xl[((rl0 + ai * HALF + m * 16) * 2 + bj) * 4 + wc] = ss; }
        asm volatile("s_waitcnt lgkmcnt(0)" ::: "memory"); __builtin_amdgcn_s_barrier(); asm volatile("" ::: "memory"); }
#pragma unroll
        for (int ai = 0; ai < 2; ++ai)
#pragma unroll
            for (int m = 0; m < 4; ++m) { const int rl = rl0 + ai * HALF + m * 16; const f32x4 rc = rcv[ai][m], rs = rsv[ai][m];
#pragma unroll
                for (int bj = 0; bj < 2; ++bj) { float rstd = 1.0f;
                    if (isk) { const f32x4 pp = *(const LAS f32x4*)(xl + (rl * 2 + bj) * 4); rstd = __builtin_amdgcn_rsqf(((pp[0] + pp[1]) + (pp[2] + pp[3])) * (1.0f / HD) + EPS); }
                    const f32x4 y0 = acc[ai][bj][m][0] * rstd * gk0, y1 = acc[ai][bj][m][1] * rstd * gk1;
                    if (!lat) { *(f32x4*)(cout + (size_t)rl * KVW + bj * HALF + base) = y0; *(f32x4*)(cout + (size_t)rl * KVW + bj * HALF + base + 32) = y1; }
                    const f32x4 z0 = y0 * rc - y1 * rs, z1 = y1 * rc + y0 * rs;
                    u32x2 w0, w1; w0.x = cvt_pk_bf16(z0[0], z0[1]); w0.y = cvt_pk_bf16(z0[2], z0[3]); w1.x = cvt_pk_bf16(z1[0], z1[1]); w1.y = cvt_pk_bf16(z1[2], z1[3]);
                    *(u32x2*)(kvdst + (size_t)rl * KVW + bj * HALF + base) = w0; *(u32x2*)(kvdst + (size_t)rl * KVW + bj * HALF + base + 32) = w1; } }
    }
};
struct EpiResid {
    static constexpr bool PERM = true, AFTER_DRAIN = false;
    bf16_t* xb; const float* gate; bf16_t* side; int dry;
    __device__ __forceinline__ void operator()(const f32x4 (&acc)[2][2][4][2], const Unit& u, int wr, int wc, int fr, int fq) const {
        if (dry == 1) return;
        const int row0 = u.pm * BM + wr * 64 + fr, col0 = u.pn * BM + wc * 32 + 8 * fq;
        const int grp = u.pm < (M_CTX / BM) ? 0 : 1 + ((u.pm - M_CTX / BM) >> 2);
        const float* gp = gate + (size_t)grp * (6 * DM) + col0;
        f32x4 gv[2][2];
#pragma unroll
        for (int bj = 0; bj < 2; ++bj)
#pragma unroll
            for (int n = 0; n < 2; ++n) gv[bj][n] = *(const f32x4*)(gp + bj * HALF + 4 * n);
        if (u.aux) {
            bf16_t* sp = side + (size_t)(row0 - M_CTX) * DM + col0;
#pragma unroll
            for (int ai = 0; ai < 2; ++ai)
#pragma unroll
                for (int m = 0; m < 4; ++m)
#pragma unroll
                    for (int bj = 0; bj < 2; ++bj) { const f32x4 v0 = gv[bj][0] * acc[ai][bj][m][0], v1 = gv[bj][1] * acc[ai][bj][m][1];
                        u32x4 w; w.x = cvt_pk_bf16(v0[0], v0[1]); w.y = cvt_pk_bf16(v0[2], v0[3]); w.z = cvt_pk_bf16(v1[0], v1[1]); w.w = cvt_pk_bf16(v1[2], v1[3]);
                        *(u32x4*)(sp + (size_t)(ai * HALF + m * 16) * DM + bj * HALF) = w; }
            return;
        }
        bf16_t* xp = xb + (size_t)row0 * DM + col0;
        u32x4 bq[2][4][2];
#pragma unroll
        for (int ai = 0; ai < 2; ++ai)
#pragma unroll
            for (int m = 0; m < 4; ++m)
#pragma unroll
                for (int bj = 0; bj < 2; ++bj) bq[ai][m][bj] = *(const u32x4*)(xp + (size_t)(ai * HALF + m * 16) * DM + bj * HALF);
#pragma unroll
        for (int ai = 0; ai < 2; ++ai)
#pragma unroll
            for (int m = 0; m < 4; ++m)
#pragma unroll
                for (int bj = 0; bj < 2; ++bj) { const u32x4 b = bq[ai][m][bj]; const f32x4 a0 = gv[bj][0] * acc[ai][bj][m][0], a1 = gv[bj][1] * acc[ai][bj][m][1];
                    if (dry == 2 && u.pm < M_CTX / BM) { float* yp = mk_out_ptr() + OUT_Y + (size_t)(row0 + ai * HALF + m * 16) * DM + col0 + bj * HALF;
                        __builtin_nontemporal_store((f32x4){bflo(b.x) + a0[0], bfhi(b.x) + a0[1], bflo(b.y) + a0[2], bfhi(b.y) + a0[3]}, (f32x4*)yp);
                        __builtin_nontemporal_store((f32x4){bflo(b.z) + a1[0], bfhi(b.z) + a1[1], bflo(b.w) + a1[2], bfhi(b.w) + a1[3]}, (f32x4*)(yp + 4)); continue; }
                    u32x4 w; w.x = cvt_pk_bf16(bflo(b.x) + a0[0], bfhi(b.x) + a0[1]); w.y = cvt_pk_bf16(bflo(b.y) + a0[2], bfhi(b.y) + a0[3]);
                    w.z = cvt_pk_bf16(bflo(b.z) + a1[0], bfhi(b.z) + a1[1]); w.w = cvt_pk_bf16(bflo(b.w) + a1[2], bfhi(b.w) + a1[3]);
                    *(u32x4*)(xp + (size_t)(ai * HALF + m * 16) * DM + bj * HALF) = w; }
    }
};

template <class Epi, class Sched, bool ALIGN_EPI = false, bool SP2 = false>
__device__ __forceinline__ void gemm_phase(LAS unsigned char* lds, const Gemm g, const Sched& S, const Epi& E) {
    const int tid = tid_fresh(), wid = __builtin_amdgcn_readfirstlane(tid >> 6), lane = tid & 63, wr = wid >> 2, wc = wid & 3, fr = lane & 15, fq = lane >> 4;
    const int K = g.K;
    unsigned voffA[2], voffB[2];
#pragma unroll
    for (int i = 0; i < 2; ++i) { int R, C; stage_rc(tid * 16 + i * 8192, R, C); const int Rb = Epi::PERM ? ((R & ~31) + perm32(R & 31)) : R;
        voffA[i] = (unsigned)(R * K + C) * 2u; voffB[i] = (unsigned)(Rb * K + C) * 2u; }
    const size_t kstep = (size_t)(BK * 2);
    const size_t hstep = (size_t)HALF * K * 2;
    const size_t tstep = 2 * hstep;
    const unsigned ldsw = (unsigned)wid * 1024u;
    const int aoff = lds_byte(wr * 64 + fr, fq * 8), boff = lds_byte(wc * 32 + fr, fq * 8);
#define PG8_SA(b, h) (((b) * 2 + (h)) * HTB)
#define PG8_SB(b, h) ((4 + (b) * 2 + (h)) * HTB)
#define PG8_STAGE(bufoff, gbase, voff) do { _Pragma("unroll") for (int _i = 0; _i < 2; ++_i) \
        __builtin_amdgcn_global_load_lds((const unsigned*)((const char*)(gbase) + (voff)[_i]), (LAS unsigned*)(lds + (bufoff) + ldsw + _i * 8192), 16, 0, 0); } while (0)
#define PG8_LDA(dst, b, h) do { _Pragma("unroll") for (int m = 0; m < 4; ++m) _Pragma("unroll") for (int k = 0; k < 2; ++k) dst[m][k] = *(const LAS bf16x8*)(lds + PG8_SA(b, h) + aoff + m * 2048 + k * 1024); } while (0)
#define PG8_LDB(dst, b, h) do { _Pragma("unroll") for (int n = 0; n < 2; ++n) _Pragma("unroll") for (int k = 0; k < 2; ++k) dst[n][k] = *(const LAS bf16x8*)(lds + PG8_SB(b, h) + boff + n * 2048 + k * 1024); } while (0)
#define PG8_MMA(ai, bj, At, Bt) do { __builtin_amdgcn_s_setprio(1); _Pragma("unroll") for (int m = 0; m < 4; ++m) _Pragma("unroll") for (int n = 0; n < 2; ++n) _Pragma("unroll") for (int k = 0; k < 2; ++k) \
        acc[ai][bj][m][n] = __builtin_amdgcn_mfma_f32_16x16x32_bf16(Bt[n][k], At[m][k], acc[ai][bj][m][n], 0, 0, 0); __builtin_amdgcn_s_setprio(0); } while (0)
#define PG8_WAIT_V(n) asm volatile("s_waitcnt vmcnt(" #n ")" ::: "memory")
#define PG8_WAIT_L(n) asm volatile("s_waitcnt lgkmcnt(" #n ")" ::: "memory")
#define PG8_BAR __builtin_amdgcn_s_barrier()
#define PG8_SCHED __builtin_amdgcn_sched_barrier(0)
    Unit cur, nxt; int ui = 0;
    if (!S.next(0, cur)) return;
    f32x4 acc[2][2][4][2];
#pragma unroll
    for (int a = 0; a < 2; ++a)
#pragma unroll
        for (int b = 0; b < 2; ++b)
#pragma unroll
            for (int m = 0; m < 4; ++m)
#pragma unroll
                for (int n = 0; n < 2; ++n) acc[a][b][m][n] = (f32x4){0.f, 0.f, 0.f, 0.f};
    bf16x8 At[4][2], B0[2][2], B1[2][2];
    const char* cA = (const char*)g.A + (size_t)cur.pm * tstep + (size_t)cur.k0 * 2; const char* cB = (const char*)g.Bt + (size_t)cur.pn * tstep + (size_t)cur.k0 * 2;
    S.a_ready(cur);
    if constexpr (SP2) {
        PG8_STAGE(PG8_SB(0, 0), cB, voffB); PG8_STAGE(PG8_SB(0, 1), cB + hstep, voffB); PG8_STAGE(PG8_SA(0, 0), cA, voffA); PG8_STAGE(PG8_SA(0, 1), cA + hstep, voffA);
        if (wr == 1) PG8_BAR;
        PG8_WAIT_V(2); PG8_BAR;
        PG8_STAGE(PG8_SB(1, 0), cB + kstep, voffB); PG8_STAGE(PG8_SA(1, 0), cA + kstep, voffA); PG8_STAGE(PG8_SB(1, 1), cB + hstep + kstep, voffB);
        PG8_WAIT_V(6); PG8_BAR;
    } else {
        PG8_STAGE(PG8_SB(0, 0), cB, voffB); PG8_STAGE(PG8_SA(0, 0), cA, voffA); PG8_STAGE(PG8_SB(0, 1), cB + hstep, voffB); PG8_STAGE(PG8_SA(0, 1), cA + hstep, voffA);
        if (wr == 1) PG8_BAR;
        PG8_WAIT_V(4); PG8_BAR;
        PG8_STAGE(PG8_SB(1, 0), cB + kstep, voffB); PG8_STAGE(PG8_SA(1, 0), cA + kstep, voffA); PG8_STAGE(PG8_SB(1, 1), cB + hstep + kstep, voffB);
        PG8_WAIT_V(6); PG8_BAR;
    }
    for (;;) {
        const bool has_next = S.next(ui + 1, nxt);
        const char* nA = has_next ? (const char*)g.A + (size_t)nxt.pm * tstep + (size_t)nxt.k0 * 2 : cA; const char* nB = has_next ? (const char*)g.Bt + (size_t)nxt.pn * tstep + (size_t)nxt.k0 * 2 : cB;
        const int nt = cur.nt;
        for (int t = 0; t < nt; t += 2) {
            const bool last = (t == nt - 2);
            const char* a1 = cA + (size_t)(t + 1) * kstep;
            const char* a2 = last ? nA : cA + (size_t)(t + 2) * kstep; const char* b2 = last ? nB : cB + (size_t)(t + 2) * kstep;
            const char* a3 = a2 + kstep; const char* b3 = b2 + kstep;
            if (last && has_next) S.a_ready(nxt);
            if constexpr (SP2) {
            PG8_LDB(B0, 0, 0); PG8_LDB(B1, 0, 1); PG8_SCHED; PG8_LDA(At, 0, 0); PG8_STAGE(PG8_SA(1, 1), a1 + hstep, voffA);
            PG8_WAIT_V(8); PG8_WAIT_L(0); PG8_BAR; PG8_MMA(0, 0, At, B0); PG8_MMA(0, 1, At, B1); PG8_BAR; PG8_SCHED;
            PG8_LDA(At, 0, 1); PG8_STAGE(PG8_SB(0, 0), b2, voffB); PG8_STAGE(PG8_SB(0, 1), b2 + hstep, voffB); PG8_STAGE(PG8_SA(0, 0), a2, voffA);
            PG8_WAIT_V(8); PG8_WAIT_L(0); PG8_BAR; PG8_MMA(1, 0, At, B0); PG8_MMA(1, 1, At, B1); PG8_BAR; PG8_SCHED;
            PG8_LDB(B0, 1, 0); PG8_LDB(B1, 1, 1); PG8_SCHED; PG8_LDA(At, 1, 0); PG8_STAGE(PG8_SA(0, 1), a2 + hstep, voffA);
            PG8_WAIT_V(8); PG8_WAIT_L(0); PG8_BAR; PG8_MMA(0, 0, At, B0); PG8_MMA(0, 1, At, B1); PG8_BAR; PG8_SCHED;
            PG8_LDA(At, 1, 1); PG8_STAGE(PG8_SB(1, 0), b3, voffB); PG8_STAGE(PG8_SB(1, 1), b3 + hstep, voffB); PG8_STAGE(PG8_SA(1, 0), a3, voffA);
            PG8_WAIT_V(8); PG8_WAIT_L(0); PG8_BAR; PG8_MMA(1, 0, At, B0); PG8_MMA(1, 1, At, B1); PG8_BAR; PG8_SCHED;
            } else {
            PG8_LDB(B0, 0, 0); PG8_SCHED; PG8_LDA(At, 0, 0); PG8_STAGE(PG8_SA(1, 1), a1 + hstep, voffA);
            PG8_WAIT_L(8); PG8_BAR; PG8_WAIT_L(0); PG8_MMA(0, 0, At, B0); PG8_BAR; PG8_SCHED;
            PG8_LDB(B1, 0, 1); PG8_STAGE(PG8_SB(0, 0), b2, voffB);
            PG8_BAR; PG8_WAIT_L(0); PG8_MMA(0, 1, At, B1); PG8_BAR;
            PG8_LDA(At, 0, 1); PG8_STAGE(PG8_SA(0, 0), a2, voffA);
            PG8_BAR; PG8_WAIT_L(0); PG8_MMA(1, 0, At, B0); PG8_BAR; PG8_SCHED;
            PG8_STAGE(PG8_SB(0, 1), b2 + hstep, voffB);
            PG8_WAIT_V(6); PG8_BAR; PG8_MMA(1, 1, At, B1); PG8_BAR;
            PG8_LDB(B0, 1, 0); PG8_SCHED; PG8_LDA(At, 1, 0); PG8_STAGE(PG8_SA(0, 1), a2 + hstep, voffA);
            PG8_WAIT_L(8); PG8_BAR; PG8_WAIT_L(0); PG8_MMA(0, 0, At, B0); PG8_BAR; PG8_SCHED;
            PG8_LDB(B1, 1, 1); PG8_STAGE(PG8_SB(1, 0), b3, voffB);
            PG8_BAR; PG8_WAIT_L(0); PG8_MMA(0, 1, At, B1); PG8_BAR;
            PG8_LDA(At, 1, 1); PG8_STAGE(PG8_SA(1, 0), a3, voffA);
            PG8_BAR; PG8_WAIT_L(0); PG8_MMA(1, 0, At, B0); PG8_BAR; PG8_SCHED;
            PG8_STAGE(PG8_SB(1, 1), b3 + hstep, voffB);
            PG8_WAIT_V(6); PG8_BAR; PG8_MMA(1, 1, At, B1); PG8_BAR;
            }
        }
        if constexpr (ALIGN_EPI) { if (wr == 0) PG8_BAR; }
        if constexpr (!Epi::AFTER_DRAIN) { E(acc, cur, wr, wc, fr, fq); S.done(cur); }
        if (!has_next) break;
#pragma unroll
        for (int a = 0; a < 2; ++a)
#pragma unroll
            for (int b = 0; b < 2; ++b)
#pragma unroll
                for (int m = 0; m < 4; ++m)
#pragma unroll
                    for (int n = 0; n < 2; ++n) acc[a][b][m][n] = (f32x4){0.f, 0.f, 0.f, 0.f};
        cur = nxt; cA = nA; cB = nB; ++ui;
        if constexpr (ALIGN_EPI) { if (wr == 1) PG8_BAR; }
    }
    PG8_WAIT_V(0);
    if constexpr (!ALIGN_EPI) { if (wr == 0) PG8_BAR; }
    PG8_BAR;
#undef PG8_SA
#undef PG8_SB
#undef PG8_STAGE
#undef PG8_LDA
#undef PG8_LDB
#undef PG8_MMA
#undef PG8_WAIT_V
#undef PG8_WAIT_L
#undef PG8_BAR
#undef PG8_SCHED
}
}

namespace att {
constexpr int D = 128, NW = 8, QBLK = 32, KVBLK = 64;
constexpr float SCALE = 0.088388347648318440f;
constexpr float THR = 8.f;
constexpr size_t SHM_V = KVBLK * D * 2, SHM_K = KVBLK * D * 2, SHM_ATTN = 2 * SHM_V + 2 * SHM_K + NW * 64 * 4;
#define KSWZ(row, colB) ((row) * 256 + ((colB) ^ (((row) & 7) << 4)))
#define SBAR() __builtin_amdgcn_sched_barrier(0)
__device__ __forceinline__ int crow(int r, int hi) { return (r & 3) + 8 * (r >> 2) + 4 * hi; }
__device__ __forceinline__ unsigned cvtpk(float lo, float hi) { unsigned r; asm volatile("v_cvt_pk_bf16_f32 %0, %1, %2" : "=v"(r) : "v"(lo), "v"(hi)); return r; }

__device__ __forceinline__ void partialSM(f32x16& p0, f32x16& p1, float& m_reg, float& mn, float& alpha) {
  constexpr float C = SCALE * 1.4426950408889634f;
  float pmax = p0[0];
#pragma unroll
  for (int r = 1; r < 16; ++r) pmax = fmaxf(pmax, p0[r]);
#pragma unroll
  for (int r = 0; r < 16; ++r) pmax = fmaxf(pmax, p1[r]);
  { auto rr = __builtin_amdgcn_permlane32_swap(__float_as_uint(pmax), __float_as_uint(pmax), false, false);
    pmax = fmaxf(__uint_as_float(rr[0]), __uint_as_float(rr[1])); }
  if (__builtin_expect(__all(pmax - m_reg <= THR / SCALE), 1)) { mn = m_reg; alpha = 1.f; }
  else { mn = fmaxf(m_reg, pmax); alpha = __builtin_amdgcn_exp2f((m_reg - mn) * C); m_reg = mn; }
  float mnC = -mn * C;
#pragma unroll
  for (int r = 0; r < 16; ++r) p0[r] = fmaf(p0[r], C, mnC);
#pragma unroll
  for (int r = 0; r < 16; ++r) p1[r] = fmaf(p1[r], C, mnC);
#pragma unroll
  for (int r = 0; r < 16; ++r) p0[r] = __builtin_amdgcn_exp2f(p0[r]);
}
__device__ __forceinline__ void finishSM(f32x16& p0, f32x16& p1, float alpha, float& l_reg, bf16x8& pa0, bf16x8& pa1, bf16x8& pa2, bf16x8& pa3) {
#pragma unroll
  for (int r = 0; r < 16; ++r) p1[r] = __builtin_amdgcn_exp2f(p1[r]);
  float ps = 0;
#pragma unroll
  for (int r = 0; r < 16; ++r) ps += p0[r];
#pragma unroll
  for (int r = 0; r < 16; ++r) ps += p1[r];
  { auto rr = __builtin_amdgcn_permlane32_swap(__float_as_uint(ps), __float_as_uint(ps), false, false);
    ps = __uint_as_float(rr[0]) + __uint_as_float(rr[1]); }
  l_reg = l_reg * alpha + ps;
#define PK4(P, BASE, OUT) do { unsigned a0 = cvtpk(P[BASE + 0], P[BASE + 1]), a1 = cvtpk(P[BASE + 2], P[BASE + 3]);   \
    unsigned b0 = cvtpk(P[BASE + 4], P[BASE + 5]), b1 = cvtpk(P[BASE + 6], P[BASE + 7]);                              \
    auto r0 = __builtin_amdgcn_permlane32_swap(a0, b0, false, false); auto r1 = __builtin_amdgcn_permlane32_swap(a1, b1, false, false); \
    u32x4 w = {r0[0], r1[0], r0[1], r1[1]}; OUT = __builtin_bit_cast(bf16x8, w); } while (0)
  PK4(p0, 0, pa0); PK4(p0, 8, pa1); PK4(p1, 0, pa2); PK4(p1, 8, pa3);
#undef PK4
}
__device__ __forceinline__ void qkt(f32x16& p0, f32x16& p1, const char* Ks, const bf16x8* qr, int r32, int hi) {
  p0 = f32x16{}; p1 = f32x16{};
#pragma unroll
  for (int d0 = 0; d0 < 8; ++d0) { int cb = (d0 * 16 + hi * 8) * 2;
    bf16x8 b0 = *reinterpret_cast<const bf16x8*>(Ks + KSWZ(r32, cb));
    bf16x8 b1 = *reinterpret_cast<const bf16x8*>(Ks + KSWZ(32 + r32, cb));
    p0 = __builtin_amdgcn_mfma_f32_32x32x16_bf16(b0, qr[d0], p0, 0, 0, 0);
    p1 = __builtin_amdgcn_mfma_f32_32x32x16_bf16(b1, qr[d0], p1, 0, 0, 0); }
}
__device__ __forceinline__ int v_st(int k, int c) { const int kk = (k & ~0xC) | ((k & 4) << 1) | ((k & 8) >> 1); return ((kk >> 3) * 4 + (c >> 5)) * 512 + ((kk & 7) * 32 + (c & 31)) * 2; }
__device__ __forceinline__ int v_rd_base(int lane) { return ((lane & 3) << 3) | (((lane >> 2) & 3) << 6) | (((lane >> 4) & 1) << 5) | (((lane >> 5) & 1) << 8); }
constexpr int v_rd_off(int d0, int ks, int half) { return d0 * 512 + ks * 4096 + half * 2048; }
template <int OFF> __device__ __forceinline__ s16x4 tr_read(int vb) {
  s16x4 r; asm volatile("ds_read_b64_tr_b16 %0, %1 offset:%2" : "=&v"(r) : "v"(vb), "i"(OFF) : "memory"); return r;
}
template <int D0> __device__ __forceinline__ void pv_one(f32x16& od, int vb, bf16x8 pa0, bf16x8 pa1, bf16x8 pa2, bf16x8 pa3) {
  const s16x4 l0 = tr_read<v_rd_off(D0, 0, 0)>(vb), h0 = tr_read<v_rd_off(D0, 0, 1)>(vb), l1 = tr_read<v_rd_off(D0, 1, 0)>(vb), h1 = tr_read<v_rd_off(D0, 1, 1)>(vb);
  const s16x4 l2 = tr_read<v_rd_off(D0, 2, 0)>(vb), h2 = tr_read<v_rd_off(D0, 2, 1)>(vb), l3 = tr_read<v_rd_off(D0, 3, 0)>(vb), h3 = tr_read<v_rd_off(D0, 3, 1)>(vb);
  asm volatile("s_waitcnt lgkmcnt(0)" ::: "memory"); SBAR();
#define PK(L, H) (bf16x8){L[0], L[1], L[2], L[3], H[0], H[1], H[2], H[3]}
  od = __builtin_amdgcn_mfma_f32_32x32x16_bf16(pa0, PK(l0, h0), od, 0, 0, 0);
  od = __builtin_amdgcn_mfma_f32_32x32x16_bf16(pa1, PK(l1, h1), od, 0, 0, 0);
  od = __builtin_amdgcn_mfma_f32_32x32x16_bf16(pa2, PK(l2, h2), od, 0, 0, 0);
  od = __builtin_amdgcn_mfma_f32_32x32x16_bf16(pa3, PK(l3, h3), od, 0, 0, 0);
#undef PK
}
__device__ __forceinline__ void pv_d0(f32x16* o, int vb, bf16x8 pa0, bf16x8 pa1, bf16x8 pa2, bf16x8 pa3) {
  pv_one<0>(o[0], vb, pa0, pa1, pa2, pa3); pv_one<1>(o[1], vb, pa0, pa1, pa2, pa3); pv_one<2>(o[2], vb, pa0, pa1, pa2, pa3); pv_one<3>(o[3], vb, pa0, pa1, pa2, pa3);
}
__device__ __forceinline__ void attn_dense_body(const bf16_t* __restrict__ Qb, const bf16_t* __restrict__ Kh, const bf16_t* __restrict__ Vh,
                                                bf16_t* __restrict__ Ob, int seq, int ldq, int ldk, int ldo, char* lds, const float* __restrict__ qn, const float* __restrict__ rope0) {
  const int tid = tid_fresh(), wid = tid >> 6, lane = tid & 63, r32 = lane & 31, hi = lane >> 5;
  char* V_lds = lds; char* K_lds = lds + 2 * SHM_V;
  float* ws = (float*)(lds + 2 * SHM_V + 2 * SHM_K) + wid * 64; float* li_l = ws; float* al_l = ws + 32;
  float m_reg = -1e30f, l_reg = 0; f32x16 o[4] = {}; bf16x8 qr[8];
  const bf16_t* Qw = Qb + (long)(wid * QBLK + r32) * ldq + hi * 8;
#pragma unroll
  for (int d0 = 0; d0 < 8; ++d0) qr[d0] = *reinterpret_cast<const bf16x8*>(Qw + d0 * 16);
  {
    float qf[8][8]; float ss = 0.f;
#pragma unroll
    for (int d0 = 0; d0 < 8; ++d0)
#pragma unroll
      for (int e = 0; e < 8; ++e) { qf[d0][e] = bf2f((unsigned short)qr[d0][e]); ss += qf[d0][e] * qf[d0][e]; }
    ss += __shfl_xor(ss, 32);
    const float rstd = 1.0f / sqrtf(ss * (1.0f / D) + EPS);
#pragma unroll
    for (int d0 = 0; d0 < 8; ++d0) { const f32x4 g0 = *(const f32x4*)(qn + d0 * 16 + hi * 8), g1 = *(const f32x4*)(qn + d0 * 16 + hi * 8 + 4);
#pragma unroll
      for (int e = 0; e < 8; ++e) qf[d0][e] *= rstd * (e < 4 ? g0[e & 3] : g1[e & 3]); }
    if (rope0 != nullptr) { const float* rp = rope0 + (long)(wid * QBLK + r32) * 128 + hi * 8;
#pragma unroll
      for (int ax = 0; ax < 2; ++ax)
#pragma unroll
        for (int dl = 0; dl < 2; ++dl) { const int d0 = 4 * ax + dl;
          const f32x4 c0 = *(const f32x4*)(rp + ax * 64 + dl * 16), c1 = *(const f32x4*)(rp + ax * 64 + dl * 16 + 4), s0 = *(const f32x4*)(rp + ax * 64 + 32 + dl * 16), s1 = *(const f32x4*)(rp + ax * 64 + 32 + dl * 16 + 4);
#pragma unroll
          for (int e = 0; e < 8; ++e) { const float c = e < 4 ? c0[e & 3] : c1[e & 3], sn = e < 4 ? s0[e & 3] : s1[e & 3]; const float x1 = qf[d0][e], x2 = qf[d0 + 2][e];
            qf[d0][e] = x1 * c - x2 * sn; qf[d0 + 2][e] = x2 * c + x1 * sn; } } }
#pragma unroll
    for (int d0 = 0; d0 < 8; ++d0) { u32x4 w; w.x = cvt_pk_bf16(qf[d0][0], qf[d0][1]); w.y = cvt_pk_bf16(qf[d0][2], qf[d0][3]); w.z = cvt_pk_bf16(qf[d0][4], qf[d0][5]); w.w = cvt_pk_bf16(qf[d0][6], qf[d0][7]);
      qr[d0] = __builtin_bit_cast(bf16x8, w); }
  }
  const int sr = tid >> 4, sc = (tid & 15) * 8, vst0 = v_st(sr, sc), vst1 = v_st(32 + sr, sc);
  const int vb0 = (int)(uintptr_t)V_lds + v_rd_base(lane);
  bf16x8 e_vs0, e_vs1, e_ks0, e_ks1, o_vs0, o_vs1, o_ks0, o_ks1;
#define SLOAD_E(k0) do { e_vs0 = *reinterpret_cast<const bf16x8*>(&Vh[(long)((k0) + sr) * ldk + sc]); e_vs1 = *reinterpret_cast<const bf16x8*>(&Vh[(long)((k0) + 32 + sr) * ldk + sc]); \
    e_ks0 = *reinterpret_cast<const bf16x8*>(&Kh[(long)((k0) + sr) * ldk + sc]); e_ks1 = *reinterpret_cast<const bf16x8*>(&Kh[(long)((k0) + 32 + sr) * ldk + sc]); } while (0)
#define SLOAD_O(k0) do { o_vs0 = *reinterpret_cast<const bf16x8*>(&Vh[(long)((k0) + sr) * ldk + sc]); o_vs1 = *reinterpret_cast<const bf16x8*>(&Vh[(long)((k0) + 32 + sr) * ldk + sc]); \
    o_ks0 = *reinterpret_cast<const bf16x8*>(&Kh[(long)((k0) + sr) * ldk + sc]); o_ks1 = *reinterpret_cast<const bf16x8*>(&Kh[(long)((k0) + 32 + sr) * ldk + sc]); } while (0)
#define SWRITE_E(b) do { *(bf16x8*)(V_lds + (b) * SHM_V + vst0) = e_vs0; *(bf16x8*)(V_lds + (b) * SHM_V + vst1) = e_vs1; int kc = sc * 2; \
    *(bf16x8*)(K_lds + (b) * SHM_K + KSWZ(sr, kc)) = e_ks0; *(bf16x8*)(K_lds + (b) * SHM_K + KSWZ(32 + sr, kc)) = e_ks1; } while (0)
#define SWRITE_O(b) do { *(bf16x8*)(V_lds + (b) * SHM_V + vst0) = o_vs0; *(bf16x8*)(V_lds + (b) * SHM_V + vst1) = o_vs1; int kc = sc * 2; \
    *(bf16x8*)(K_lds + (b) * SHM_K + KSWZ(sr, kc)) = o_ks0; *(bf16x8*)(K_lds + (b) * SHM_K + KSWZ(32 + sr, kc)) = o_ks1; } while (0)
#define SWAIT() asm volatile("s_waitcnt vmcnt(4)" ::: "memory")
#define RESC(a) do { if (__any((a) < 1.f)) { if (hi == 0) al_l[r32] = (a); asm volatile("s_waitcnt lgkmcnt(0)" ::: "memory"); \
    _Pragma("unroll") for (int d = 0; d < 4; ++d) _Pragma("unroll") for (int r = 0; r < 16; ++r) o[d][r] *= al_l[crow(r, hi)]; } } while (0)
  f32x16 pA0, pA1, pB0, pB1; float mnA, mnB, alA, alB; bf16x8 pa0, pa1, pa2, pa3; const int NT = seq / KVBLK;
  SLOAD_E(0); asm volatile("s_waitcnt vmcnt(0)" ::: "memory"); SWRITE_E(0); __syncthreads();
  qkt(pA0, pA1, K_lds, qr, r32, hi); partialSM(pA0, pA1, m_reg, mnA, alA);
  SLOAD_O(KVBLK); if (2 < NT) SLOAD_E(2 * KVBLK);
  SWAIT(); SWRITE_O(1); __syncthreads();
  for (int j = 1; j + 1 < NT; j += 2) {
    SBAR(); qkt(pB0, pB1, K_lds + SHM_K, qr, r32, hi);
    finishSM(pA0, pA1, alA, l_reg, pa0, pa1, pa2, pa3); SBAR();
    SLOAD_O((j + 2) * KVBLK); SBAR();
    pv_d0(o, vb0, pa0, pa1, pa2, pa3); partialSM(pB0, pB1, m_reg, mnB, alB);
    __syncthreads(); SWAIT(); SWRITE_E(0);
    RESC(alB); __syncthreads();
    SBAR(); qkt(pA0, pA1, K_lds, qr, r32, hi);
    finishSM(pB0, pB1, alB, l_reg, pa0, pa1, pa2, pa3); SBAR();
    if (j + 3 < NT) SLOAD_E((j + 3) * KVBLK); SBAR();
    pv_d0(o, vb0 + (int)SHM_V, pa0, pa1, pa2, pa3); partialSM(pA0, pA1, m_reg, mnA, alA);
    __syncthreads(); SWAIT(); SWRITE_O(1);
    RESC(alA); __syncthreads();
  }
  SBAR(); qkt(pB0, pB1, K_lds + SHM_K, qr, r32, hi);
  finishSM(pA0, pA1, alA, l_reg, pa0, pa1, pa2, pa3); SBAR();
  pv_d0(o, vb0, pa0, pa1, pa2, pa3); partialSM(pB0, pB1, m_reg, mnB, alB);
  __syncthreads(); RESC(alB);
  finishSM(pB0, pB1, alB, l_reg, pa0, pa1, pa2, pa3); SBAR();
  pv_d0(o, vb0 + (int)SHM_V, pa0, pa1, pa2, pa3);
  if (hi == 0) li_l[r32] = l_reg; asm volatile("s_waitcnt lgkmcnt(0)" ::: "memory");
  float rli[16];
#pragma unroll
  for (int r = 0; r < 16; ++r) rli[r] = __builtin_amdgcn_rcpf(li_l[crow(r, hi)]);
  bf16_t* Ow = Ob + (long)(wid * QBLK) * ldo;
#pragma unroll
  for (int r = 0; r < 16; ++r) { int orow = crow(r, hi);
#pragma unroll
    for (int d0 = 0; d0 < 4; ++d0) Ow[(long)orow * ldo + d0 * 32 + r32] = (bf16_t)(cvt_pk_bf16(o[d0][r] * rli[r], 0.f) & 0xffffu); }
#undef SLOAD_E
#undef SLOAD_O
#undef SWRITE_E
#undef SWRITE_O
#undef SWAIT
#undef RESC
}
}

#define XB_TMO      128
#define XB_XCNT(j)  (256  + 64 * (j))
#define XB_XSUB(j)  (1280 + 64 * (j))
#define XB_XGEN(j)  (2304 + 64 * (j))
#define XB_TOP      3328
#define XB_TOPGEN   3392
#define XCD_BAR_WORDS 3456
#define XB_SPIN_CAP (1u << 18)
__device__ __forceinline__ unsigned xb_ld(unsigned* p)              { return __hip_atomic_load(p, __ATOMIC_RELAXED, __HIP_MEMORY_SCOPE_AGENT); }
__device__ __forceinline__ unsigned xb_add(unsigned* p, unsigned v) { return __hip_atomic_fetch_add(p, v, __ATOMIC_RELAXED, __HIP_MEMORY_SCOPE_AGENT); }
__device__ __forceinline__ unsigned xb_xcc_id() { return (unsigned)__builtin_amdgcn_s_getreg((3 << 11) | 20) & 0xFu; }
#define XB_SPIN(cond, bar) do { unsigned _sp = 0; while (cond) { __builtin_amdgcn_s_sleep(1); \
    if ((++_sp & 255u) == 0u) { if (xb_ld(&(bar)[XB_TMO])) break; if (_sp > XB_SPIN_CAP) { atomicAdd(&(bar)[XB_TMO], 1u); break; } } } } while (0)
struct XcdBarrier { unsigned* bar; unsigned x; volatile LAS unsigned* st; };
__device__ __forceinline__ XcdBarrier xcd_barrier_post(unsigned* bar, volatile LAS unsigned* st) {
    XcdBarrier b; b.bar = bar; b.x = xb_xcc_id(); b.st = st;
    if (threadIdx.x == 0) (void)xb_add(&bar[XB_XCNT(b.x)], 1u);
    return b;
}
__device__ __forceinline__ void xcd_barrier_complete(unsigned* bar, unsigned x, unsigned& nloc, unsigned& nx) {
    const unsigned G = gridDim.x * gridDim.y * gridDim.z;
    unsigned sum, cnt, mine, sp = 0u;
    for (;;) {
        sum = 0u; cnt = 0u; mine = 0u;
#pragma unroll
        for (unsigned j = 0; j < 16; ++j) { const unsigned c = xb_ld(&bar[XB_XCNT(j)]); sum += c; cnt += (c > 0u) ? 1u : 0u; mine = (j == x) ? c : mine; }
        if (sum == G) break;
        __builtin_amdgcn_s_sleep(1);
        if ((++sp & 255u) == 0u) { if (xb_ld(&bar[XB_TMO])) break; if (sp > XB_SPIN_CAP) { atomicAdd(&bar[XB_TMO], 1u); break; } }
    }
    nloc = mine > 0u ? mine : 1u; nx = cnt > 0u ? cnt : 1u;
}
__device__ __forceinline__ void xcd_barrier(const XcdBarrier& b) {
    asm volatile("s_waitcnt vmcnt(0)" ::: "memory");
    __syncthreads();
    if (threadIdx.x == 0) {
        unsigned* bar = b.bar;
        __builtin_amdgcn_s_waitcnt(0);
        unsigned nloc = b.st[0], nx = b.st[1];
        if (nloc == 0u) { xcd_barrier_complete(bar, b.x, nloc, nx); b.st[0] = nloc; b.st[1] = nx; }
        const unsigned old = xb_add(&bar[XB_XSUB(b.x)], 1u);
        const unsigned gen = old / nloc;
        if (old + 1u == (gen + 1u) * nloc) {
            __builtin_amdgcn_fence(__ATOMIC_RELEASE, "agent");
            asm volatile("s_waitcnt vmcnt(0)" ::: "memory");
            const unsigned og = xb_add(&bar[XB_TOP], 1u);
            const unsigned tg = og / nx;
            if (og + 1u == (tg + 1u) * nx) xb_add(&bar[XB_TOPGEN], 1u);
            else XB_SPIN(xb_ld(&bar[XB_TOPGEN]) == tg, bar);
            __builtin_amdgcn_fence(__ATOMIC_ACQUIRE, "agent");
            xb_add(&bar[XB_XGEN(b.x)], 1u);
            asm volatile("s_waitcnt vmcnt(0)" ::: "memory");
        } else {
            XB_SPIN(xb_ld(&bar[XB_XGEN(b.x)]) == gen, bar);
            __builtin_amdgcn_fence(__ATOMIC_ACQUIRE, "agent");
            asm volatile("s_waitcnt vmcnt(0)" ::: "memory");
        }
    }
    __syncthreads();
}

struct Args {
    const float* x_prompt; const float* x_sample; const float* cache_k; const float* cache_v; const float* st_f; const float* st_b; const float* c; const float* c_ctx;
    const float* w_mod; const float* b_mod; const float* norm1; const float* w_in; const float* q_norm; const float* k_norm; const float* wg_f; const float* bg_f;
    const float* wg_b; const float* bg_b; const float* gla_norm; const float* w_out; const float* norm2; const float* w_up; const float* w_down;
    float* out; unsigned char* ws; int ph_lo, ph_hi;
};
static_assert(sizeof(Args) == 25 * 8 + 8, "Args has no padding");
typedef const __attribute__((address_space(4))) Args* KArgsP;
__device__ __forceinline__ KArgsP ka_get() { KArgsP p = (KArgsP)__builtin_amdgcn_kernarg_segment_ptr(); asm volatile("" : "+s"(p)); return p; }
__device__ __forceinline__ float* mk_out_ptr() { return ka_get()->out; }

__device__ __forceinline__ float wave_sum(float v) {
#pragma unroll
    for (int o = 1; o < 64; o <<= 1) v += __shfl_xor(v, o);
    return v;
}
__device__ __forceinline__ float half_sum(float v) {
#pragma unroll
    for (int o = 1; o < 32; o <<= 1) v += __shfl_xor(v, o);
    return v;
}
__device__ __forceinline__ float silu_f(float x) { return x / (1.f + __expf(-x)); }
__device__ __forceinline__ float logsigmoid_f(float z) { return fminf(z, 0.f) - log1pf(__expf(-fabsf(z))); }

__device__ __forceinline__ int win_row(int ncol) {
    if (ncol >= C_QG && ncol < C_KG) return C_QG + ((ncol - C_QG) >> 6) * 256 + ((ncol - C_QG) & 63);
    if (ncol >= C_KG && ncol < C_VG) return C_QG + ((ncol - C_KG) >> 6) * 256 + 64 + ((ncol - C_KG) & 63);
    if (ncol >= C_VG && ncol < C_OG) return C_QG + ((ncol - C_VG) >> 7) * 256 + 128 + ((ncol - C_VG) & 127);
    if (ncol < C_K || ncol >= C_V + 2 * HD) return ncol;
    const int hh = (ncol - C_K) >> 7, d = (ncol - C_K) & 127, half64 = d >> 6, r = d & 63, nn = r >> 5, r5 = r & 31, g = half64 * 8 + (r5 >> 2), j = r5 & 3;
    return C_K + hh * 128 + 32 * (g >> 2) + 8 * (g & 3) + 4 * nn + j;
}
template <bool REMAP>
__device__ __forceinline__ void p0_transpose_item(const float* W, int K, int N, bf16_t* WT, LAS float* scr, int item, int lane) {
    const int nblk = N / 32, kb = item / nblk, nb = item % nblk, k0 = 64 * kb, n0 = 32 * nb;
#pragma unroll 8
    for (int i = 0; i < 32; ++i) { const int kk = 2 * i + (lane >> 5); scr[kk * 33 + (lane & 31)] = PRO_NT ? __builtin_nontemporal_load(&W[(size_t)(k0 + kk) * N + n0 + (lane & 31)]) : W[(size_t)(k0 + kk) * N + n0 + (lane & 31)]; }
    LDS_WAIT(); asm volatile("" ::: "memory");
    const int c = lane & 7;
#pragma unroll
    for (int j = 0; j < 4; ++j) { const int n = (lane >> 3) + 8 * j; const LAS float* s = scr + (8 * c) * 33 + n;
        u32x4 o; o.x = pk2(s[0 * 33], s[1 * 33]); o.y = pk2(s[2 * 33], s[3 * 33]); o.z = pk2(s[4 * 33], s[5 * 33]); o.w = pk2(s[6 * 33], s[7 * 33]);
        if (PRO_NT) __builtin_nontemporal_store(o, (u32x4*)(WT + (size_t)(REMAP ? win_row(n0 + n) : n0 + n) * K + k0 + 8 * c)); else *(u32x4*)(WT + (size_t)(REMAP ? win_row(n0 + n) : n0 + n) * K + k0 + 8 * c) = o; }
    LDS_WAIT(); asm volatile("" ::: "memory");
}

constexpr int CW_IN = (DM / 64) * (PROJ_W / 32), CW_OUT = (DM / 64) * (DM / 32), CW_UP = (DM / 64) * (DFF / 32), CW_DN = (DFF / 64) * (DM / 32), CW_IL = CW_IN + CW_OUT + CW_UP + CW_DN;
__device__ __forceinline__ void convert_weights(KArgsP ap, LAS unsigned char* lds, int lo, int hi, int part, int nparts) {
    const int tid = tid_fresh(), lane = tid & 63, wave = __builtin_amdgcn_readfirstlane(tid >> 6);
    unsigned char* ws = ap->ws;
    LAS float* scr = (LAS float*)(lds + wave * 16384);
    for (int it = lo + part * 8 + wave; it < hi; it += nparts * 8) {
        const int l = it / CW_IL; int r = it % CW_IL;
        if (r < CW_IN) { p0_transpose_item<true>(ap->w_in + (size_t)l * DM * PROJ_W, DM, PROJ_W, (bf16_t*)(ws + WS_WIN) + (size_t)l * PROJ_P * DM, scr, r, lane); continue; } r -= CW_IN;
        if (r < CW_OUT) { p0_transpose_item<false>(ap->w_out + (size_t)l * DM * DM, DM, DM, (bf16_t*)(ws + WS_WOUT) + (size_t)l * DM * DM, scr, r, lane); continue; } r -= CW_OUT;
        if (r < CW_UP) { p0_transpose_item<false>(ap->w_up + (size_t)l * DM * DFF, DM, DFF, (bf16_t*)(ws + WS_WUP) + (size_t)l * DFF * DM, scr, r, lane); continue; } r -= CW_UP;
        p0_transpose_item<false>(ap->w_down + (size_t)l * DFF * DM, DFF, DM, (bf16_t*)(ws + WS_WDN) + (size_t)l * DM * DFF, scr, r, lane);
    }
}

__device__ __forceinline__ void phase_prologue(KArgsP ap, LAS unsigned char* lds, int G) {
    const int tid = tid_fresh(), lane = tid & 63, wave = __builtin_amdgcn_readfirstlane(tid >> 6);
    unsigned char* ws = ap->ws;
    float* MOD = (float*)(ws + WS_MOD);
    {
        LAS float* sv = (LAS float*)lds;
        LAS float* red = (LAS float*)(lds + 40960);
        for (int i = tid; i < NGRP * DM; i += 512) { const int v = i / DM, k = i % DM; const float x = (v == 0) ? ap->c_ctx[k] : ap->c[(v - 1) * DM + k]; sv[i] = silu_f(x); }
        __syncthreads();
        const int kg = tid >> 4, cl = tid & 15;
        for (int it = blockIdx.x; it < DEPTH * (6 * DM / 64); it += G) {
            const int l = it / (6 * DM / 64), n0 = (it % (6 * DM / 64)) * 64;
            const float* wp = ap->w_mod + ((size_t)l * DM + kg * 64) * (6 * DM) + n0 + 4 * cl;
            f32x4 acc[NGRP];
#pragma unroll
            for (int v = 0; v < NGRP; ++v) acc[v] = (f32x4){0.f, 0.f, 0.f, 0.f};
#pragma unroll 8
            for (int kk = 0; kk < 64; ++kk) { const f32x4 w = PRO_NT ? __builtin_nontemporal_load((const f32x4*)(wp + (size_t)kk * (6 * DM))) : *(const f32x4*)(wp + (size_t)kk * (6 * DM));
#pragma unroll
                for (int v = 0; v < NGRP; ++v) acc[v] += w * sv[v * DM + kg * 64 + kk]; }
#pragma unroll
            for (int v = 0; v < NGRP; ++v) *(LAS f32x4*)(red + (kg * NGRP + v) * 64 + 4 * cl) = acc[v];
            __syncthreads();
            if (tid < NGRP * 64) { const int v = tid >> 6, n = tid & 63; float s = 0.f;
                for (int g2 = 0; g2 < 32; ++g2) s += red[(g2 * NGRP + v) * 64 + n];
                MOD[((size_t)l * NGRP + v) * (6 * DM) + n0 + n] = s + ap->b_mod[(size_t)l * (6 * DM) + n0 + n]; }
            __syncthreads();
        }
    }
    __syncthreads();
    const int gw = blockIdx.x * 8 + wave, NGW = G * 8;
    const size_t gt = (size_t)blockIdx.x * 512 + tid, NGT = (size_t)G * 512;
    convert_weights(ap, lds, 0, (CONV_TAILS ? 2 : 4) * CW_IL, blockIdx.x, G);
    {
        constexpr size_t PADV = (size_t)(PROJ_P - PROJ_W) * DM * 2 / 16;
        for (size_t i = gt; i < DEPTH * PADV; i += NGT) { const size_t l = i / PADV, r = i % PADV;
            *(u32x4*)(ws + WS_WIN + (l * PROJ_P + PROJ_W) * (size_t)DM * 2 + r * 16) = (u32x4){0u, 0u, 0u, 0u}; }
    }
    {
        float* RP = (float*)(ws + WS_ROPE);
        for (size_t i = gt; i < (size_t)S_LAT * 64; i += NGT) { const int t = (int)(i >> 6), j = (int)(i & 63), ax = j >> 5, fi = j & 31;
            const float pos = (float)(ax == 0 ? (t >> 6) : (t & 63));
            const float inv = exp2f(-(float)fi * (13.287712379549449f / 32.f));
            const float rev = pos * inv * 0.15915494309189535f; const float fr = rev - floorf(rev);
            RP[(size_t)t * 128 + ax * 64 + fi] = __builtin_amdgcn_cosf(fr); RP[(size_t)t * 128 + ax * 64 + 32 + fi] = __builtin_amdgcn_sinf(fr); }
    }
    {
        constexpr size_t NV = (size_t)NB_LAT * DEPTH * PAST * KVW / 4;
        for (size_t i = gt; i < 2 * NV; i += NGT) { const bool isv = i >= NV; const size_t j = isv ? i - NV : i;
            const size_t e = j * 4, b = e / ((size_t)DEPTH * PAST * KVW), rem = e % ((size_t)DEPTH * PAST * KVW), l = rem / ((size_t)PAST * KVW), sc = rem % ((size_t)PAST * KVW);
            const f32x4 v = *(const f32x4*)((isv ? ap->cache_v : ap->cache_k) + e);
            u32x2 o; o.x = pk2(v[0], v[1]); o.y = pk2(v[2], v[3]);
            *(u32x2*)((bf16_t*)(ws + (isv ? WS_VL : WS_KL)) + ((l * NB_LAT + b) * S_KVL) * KVW + sc) = o; }
    }
}

__device__ __forceinline__ void phase_norm(bf16_t* XB, const bf16_t* side, const float* nw, const float* mod_l  , int off_shift, int off_scale, bf16_t* H, int G, bool from_inputs = false) {
    const int tid = tid_fresh(), lane = tid & 63, wave = __builtin_amdgcn_readfirstlane(tid >> 6);
    const int gw = blockIdx.x * 8 + wave, NGW = G * 8;
    constexpr int RB = 3;
    int cur_grp = -1; f32x4 gm[4][2], sh[4][2];
    for (int row = gw * RB; row < M; row += NGW * RB) {
        u32x4 xv[RB][4];
        if (from_inputs) {
            KArgsP ka = ka_get();
#pragma unroll
            for (int rr = 0; rr < RB; ++rr) { const int r = row + rr; const float* src = (r < M_CTX ? ka->x_prompt + (size_t)r * DM : ka->x_sample + (size_t)(r - M_CTX) * DM) + 8 * lane;
                f32x4 fa[4], fb[4];
#pragma unroll
                for (int j = 0; j < 4; ++j) { fa[j] = __builtin_nontemporal_load((const f32x4*)(src + 512 * j)); fb[j] = __builtin_nontemporal_load((const f32x4*)(src + 512 * j + 4)); }
#pragma unroll
                for (int j = 0; j < 4; ++j) { u32x4 w; w.x = cvt_pk_bf16(fa[j][0], fa[j][1]); w.y = cvt_pk_bf16(fa[j][2], fa[j][3]); w.z = cvt_pk_bf16(fb[j][0], fb[j][1]); w.w = cvt_pk_bf16(fb[j][2], fb[j][3]);
                    xv[rr][j] = w; *(u32x4*)(XB + (size_t)r * DM + 8 * lane + 512 * j) = w; } } }
        else {
#pragma unroll
        for (int rr = 0; rr < RB; ++rr)
#pragma unroll
            for (int j = 0; j < 4; ++j) xv[rr][j] = *(const u32x4*)(XB + (size_t)(row + rr) * DM + 8 * lane + 512 * j); }
        if (side != nullptr && row + RB > M_CTX) {
#pragma unroll
            for (int rr = 0; rr < RB; ++rr) { const int r = row + rr;
                if (r >= M_CTX) {
#pragma unroll
                    for (int j = 0; j < 4; ++j) { const u32x4 sv = __builtin_nontemporal_load((const u32x4*)(side + (size_t)(r - M_CTX) * DM + 8 * lane + 512 * j)); u32x4 w = xv[rr][j];
                        w.x = cvt_pk_bf16(bflo(w.x) + bflo(sv.x), bfhi(w.x) + bfhi(sv.x)); w.y = cvt_pk_bf16(bflo(w.y) + bflo(sv.y), bfhi(w.y) + bfhi(sv.y));
                        w.z = cvt_pk_bf16(bflo(w.z) + bflo(sv.z), bfhi(w.z) + bfhi(sv.z)); w.w = cvt_pk_bf16(bflo(w.w) + bflo(sv.w), bfhi(w.w) + bfhi(sv.w));
                        xv[rr][j] = w; *(u32x4*)(XB + (size_t)r * DM + 8 * lane + 512 * j) = w; } } } }
#pragma unroll
        for (int rr = 0; rr < RB; ++rr) { const int r = row + rr;
            const int grp = r < M_CTX ? 0 : 1 + (r - M_CTX) / S_LAT;
            if (grp != cur_grp) { cur_grp = grp; const float* mp = mod_l + (size_t)grp * (6 * DM);
#pragma unroll
                for (int j = 0; j < 4; ++j)
#pragma unroll
                    for (int q = 0; q < 2; ++q) { const int c = 8 * lane + 512 * j + 4 * q; const f32x4 w = *(const f32x4*)(nw + c), sc = *(const f32x4*)(mp + off_scale + c);
                        gm[j][q] = w * (sc + 1.0f); sh[j][q] = *(const f32x4*)(mp + off_shift + c); } }
            float x[4][8]; float ss = 0.f;
#pragma unroll
            for (int j = 0; j < 4; ++j) { const u32x4 w = xv[rr][j];
                x[j][0] = bflo(w.x); x[j][1] = bfhi(w.x); x[j][2] = bflo(w.y); x[j][3] = bfhi(w.y); x[j][4] = bflo(w.z); x[j][5] = bfhi(w.z); x[j][6] = bflo(w.w); x[j][7] = bfhi(w.w);
#pragma unroll
                for (int e = 0; e < 8; ++e) ss += x[j][e] * x[j][e]; }
            const float rstd = 1.0f / sqrtf(wave_sum(ss) * (1.0f / DM) + EPS);
            bf16_t* hr = H + (size_t)r * DM;
#pragma unroll
            for (int j = 0; j < 4; ++j) { float y[8];
#pragma unroll
                for (int e = 0; e < 8; ++e) y[e] = x[j][e] * rstd * gm[j][e >> 2][e & 3] + sh[j][e >> 2][e & 3];
                u32x4 o; o.x = cvt_pk_bf16(y[0], y[1]); o.y = cvt_pk_bf16(y[2], y[3]); o.z = cvt_pk_bf16(y[4], y[5]); o.w = cvt_pk_bf16(y[6], y[7]);
                *(u32x4*)(hr + 8 * lane + 512 * j) = o; }
        }
    }
}

__device__ __forceinline__ void phase_prep(KArgsP a, int l, int G, int dry) {
    const int tid = tid_fresh(), lane = tid & 63, wave = __builtin_amdgcn_readfirstlane(tid >> 6);
    unsigned char* ws = a->ws;
    bf16_t* PROJ = (bf16_t*)(ws + WS_PROJ);
    const float* RP = (const float*)(ws + WS_ROPE);
    const int gw = blockIdx.x * 8 + wave, NGW = G * 8;
    const int j16 = lane & 15, sg = lane >> 4, d0 = 8 * j16;
    f32x4 gq[2], gk[2];
    { const float* qn = a->q_norm + l * HD + d0; const float* kn = a->k_norm + l * HD + d0; gq[0] = *(const f32x4*)qn; gq[1] = *(const f32x4*)(qn + 4); gk[0] = *(const f32x4*)kn; gk[1] = *(const f32x4*)(kn + 4); }
    const float sgn = (j16 & 4) ? 1.f : -1.f;
    const int rpo = (j16 >> 3) * 64 + 8 * (j16 & 3);
    float* out = a->out;
    constexpr int RB = 2;
    for (int row = gw * RB; row < M; row += NGW * RB) {
        u32x4 wv[RB][3]; f32x4 rc[RB][2], rs[RB][2];
#pragma unroll
        for (int rr = 0; rr < RB; ++rr) { const int r = row + rr; const bf16_t* pr = PROJ + (size_t)r * PROJ_P;
#pragma unroll
            for (int it = 2; it < 3; ++it) wv[rr][it] = *(const u32x4*)(pr + (4 * it + sg) * HD + d0);
            if (r >= M_CTX) { const float* rp = RP + (size_t)((r - M_CTX) % S_LAT) * 128 + rpo; rc[rr][0] = *(const f32x4*)rp; rc[rr][1] = *(const f32x4*)(rp + 4); rs[rr][0] = *(const f32x4*)(rp + 32); rs[rr][1] = *(const f32x4*)(rp + 36); }
            else { rc[rr][0] = rc[rr][1] = (f32x4){1.f, 1.f, 1.f, 1.f}; rs[rr][0] = rs[rr][1] = (f32x4){0.f, 0.f, 0.f, 0.f}; } }
#pragma unroll
        for (int rr = 0; rr < RB; ++rr) { const int r = row + rr; bf16_t* pr = PROJ + (size_t)r * PROJ_P;
            const bool lat = r >= M_CTX;
            int b, t; if (!lat) { b = r / S_CTX; t = r % S_CTX; } else { b = (r - M_CTX) / S_LAT; t = (r - M_CTX) % S_LAT; }
            bf16_t* kdst = lat ? (bf16_t*)(ws + WS_KL) + ((size_t)(l * NB_LAT + b) * S_KVL + PAST + t) * KVW : (bf16_t*)(ws + WS_KC) + (size_t)r * KVW;
            bf16_t* vdst = lat ? (bf16_t*)(ws + WS_VL) + ((size_t)(l * NB_LAT + b) * S_KVL + PAST + t) * KVW : (bf16_t*)(ws + WS_VC) + (size_t)r * KVW;
            float* ckout = out + OUT_CK + (((size_t)b * DEPTH + l) * S_CTX + t) * KVW;
            float* cvout = out + OUT_CV + (((size_t)b * DEPTH + l) * S_CTX + t) * KVW;
#pragma unroll
            for (int it = 2; it < 3; ++it) {
                const int slot = 4 * it + sg;
                const u32x4 w = wv[rr][it];
                float x[8] = {bflo(w.x), bfhi(w.x), bflo(w.y), bfhi(w.y), bflo(w.z), bfhi(w.z), bflo(w.w), bfhi(w.w)};
                if (it == 2 && sg >= 2) {
                    if (!dry) *(u32x4*)(vdst + (slot - 10) * HD + d0) = w;
                    if (!lat && !dry) { *(f32x4*)(cvout + (slot - 10) * HD + d0) = (f32x4){x[0], x[1], x[2], x[3]}; *(f32x4*)(cvout + (slot - 10) * HD + d0 + 4) = (f32x4){x[4], x[5], x[6], x[7]}; }
                }
                float ss = 0.f;
#pragma unroll
                for (int e = 0; e < 8; ++e) ss += x[e] * x[e];
                ss += __shfl_xor(ss, 1); ss += __shfl_xor(ss, 2); ss += __shfl_xor(ss, 4); ss += __shfl_xor(ss, 8);
                const float rstd = 1.0f / sqrtf(ss * (1.0f / HD) + EPS);
                const bool isk = (it == 2);
                float y[8], z[8];
#pragma unroll
                for (int e = 0; e < 8; ++e) y[e] = x[e] * rstd * (isk ? gk[e >> 2][e & 3] : gq[e >> 2][e & 3]);
#pragma unroll
                for (int e = 0; e < 8; ++e) { const float p = __shfl_xor(y[e], 4); z[e] = y[e] * rc[rr][e >> 2][e & 3] + sgn * p * rs[rr][e >> 2][e & 3]; }
                u32x4 o; o.x = cvt_pk_bf16(z[0], z[1]); o.y = cvt_pk_bf16(z[2], z[3]); o.z = cvt_pk_bf16(z[4], z[5]); o.w = cvt_pk_bf16(z[6], z[7]);
                if (dry) { if (o.x == 0x12345678u && o.y == 0x9abcdef0u) *(u32x4*)(pr + slot * HD + d0) = o; }
                else if (it < 2) *(u32x4*)(pr + slot * HD + d0) = o;
                else if (sg < 2) { *(u32x4*)(kdst + (slot - 8) * HD + d0) = o;
                    if (!lat) { *(f32x4*)(ckout + (slot - 8) * HD + d0) = (f32x4){y[0], y[1], y[2], y[3]}; *(f32x4*)(ckout + (slot - 8) * HD + d0 + 4) = (f32x4){y[4], y[5], y[6], y[7]}; } }
            }
        }
    }
}

__device__ __forceinline__ int dequeue(gu32* head, volatile LAS unsigned* slot, int tid) {
    __syncthreads();
    if (tid == 0) *slot = __hip_atomic_fetch_add((unsigned*)head, 1u, __ATOMIC_RELAXED, __HIP_MEMORY_SCOPE_AGENT);
    __syncthreads();
    return (int)*slot;
}

__device__ __forceinline__ void phase_attn(KArgsP a, int l, char* lds, gu32* head, volatile LAS unsigned* slot, int mode, int max_units) {
    const int tid = tid_fresh();
    unsigned char* ws = a->ws;
    const bf16_t* PROJ = (const bf16_t*)(ws + WS_PROJ); bf16_t* MIXA = (bf16_t*)(ws + WS_MIXA);
    const float* qnl = a->q_norm + l * HD;
    constexpr int N_LATU = NB_LAT * NQH * (S_LAT / 256), N_CTXU = NB_CTX * NQH;
    for (int nu = 0; nu < max_units; ++nu) {
        const int it = dequeue(head, slot, tid);
        if (it >= (mode == 0 ? N_LATU : N_CTXU)) break;
        int row0, h, seq; const bf16_t* kb; const bf16_t* vb;
        const float* rope0 = nullptr;
        if (mode == 0) { const int b = it / (NQH * 4), qb = it % 4; h = (it / 4) % NQH; row0 = M_CTX + b * S_LAT + qb * 256; seq = S_KVL; rope0 = (const float*)(ws + WS_ROPE) + (size_t)(qb * 256) * 128;
            kb = (const bf16_t*)(ws + WS_KL) + (size_t)(l * NB_LAT + b) * S_KVL * KVW + (h >> 2) * HD; vb = (const bf16_t*)(ws + WS_VL) + (size_t)(l * NB_LAT + b) * S_KVL * KVW + (h >> 2) * HD; }
        else { const int b = it / NQH; h = it % NQH; row0 = b * S_CTX; seq = S_CTX;
            kb = (const bf16_t*)(ws + WS_KC) + (size_t)row0 * KVW + (h >> 2) * HD; vb = (const bf16_t*)(ws + WS_VC) + (size_t)row0 * KVW + (h >> 2) * HD; }
        att::attn_dense_body(PROJ + (size_t)row0 * PROJ_P + C_Q + h * HD, kb, vb, MIXA + (size_t)row0 * DM + h * HD, seq, PROJ_P, KVW, DM, lds, qnl, rope0);
    }
}

constexpr int GL_QT = 0, GL_KT = 9216, GL_KH = 18432, GL_PP = 46080, GL_ST = 55296, GL_TOT = 73728, GL_RR = 75776, GL_DL = 79872, GL_VT = 81920  , GL_LD = 72;
__device__ __forceinline__ int crow16(int r, int hi) { return (r & 3) + 8 * (r >> 2) + 4 * hi; }
__device__ __forceinline__ unsigned short bf1(float x) { return (unsigned short)(cvt_pk_bf16(x, x) & 0xffffu); }
constexpr int N_GLA_LAT = NB_LAT * GH * 2, N_GLA_CTX = NB_CTX * GH * 2;
__device__ __forceinline__ void phase_gla(KArgsP a, int l, LAS unsigned char* lds, gu32* head, volatile LAS unsigned* slot, int mode, int G) {
    const int tid = tid_fresh(), lane = tid & 63, wave = __builtin_amdgcn_readfirstlane(tid >> 6);
    unsigned char* ws = a->ws;
    const bf16_t* PROJ = (const bf16_t*)(ws + WS_PROJ);
    LAS bf16_t* QT = (LAS bf16_t*)(lds + GL_QT); LAS bf16_t* KT = (LAS bf16_t*)(lds + GL_KT); LAS bf16_t* KH = (LAS bf16_t*)(lds + GL_KH);
    LAS bf16_t* VT = (LAS bf16_t*)(lds + GL_VT); LAS bf16_t* PP = (LAS bf16_t*)(lds + GL_PP); LAS bf16_t* ST = (LAS bf16_t*)(lds + GL_ST);
    LAS float* TOT = (LAS float*)(lds + GL_TOT); LAS float* RR = (LAS float*)(lds + GL_RR); LAS float* DL = (LAS float*)(lds + GL_DL);
    const int r32 = lane & 31, hi = lane >> 5;
    const int ste = wave >> 1, std_ = wave & 1;
    const int oti = wave >> 2, ote = wave & 3;
    int first = (mode == 0) ? (int)blockIdx.x : -1;
    int it_next = (mode == 1) ? N_GLA_LAT + dequeue(head, slot, tid) : 0;
    bool pre = false;
    float wgn[GRANK], bgn = 0.f;
    unsigned pr_r0, pr_v0[8], pr_r1, pr_v1[8], pr_q0[8], pr_k0[8], pr_q1[8], pr_k1[8];
    float qv[8], kv[8];
    const int gi_r = tid >> 3, qksh = 16 * (lane & 1);
    for (;;) {
        int it;
        if (mode == 0) { if (first < 0 || first >= N_GLA_LAT) break; it = first; first += G; }
        else { it = it_next; if (it >= N_GLA_LAT + N_GLA_CTX) break; }
        __syncthreads();
        unsigned nxt_v = 0u;
        if (mode == 1 && tid == 0) nxt_v = __hip_atomic_fetch_add((unsigned*)head, 1u, __ATOMIC_RELAXED, __HIP_MEMORY_SCOPE_AGENT);
        const bool lat = it < N_GLA_LAT; const int u = lat ? it : it - N_GLA_LAT;
        const int dir = u & 1, h = (u >> 1) % GH, b = u / (2 * GH);
        const int T = lat ? S_LAT : S_CTX, row_base = lat ? M_CTX + b * S_LAT : b * S_CTX, nch = T / 64;
        const __amdgpu_buffer_rsrc_t orsrc = __builtin_amdgcn_make_buffer_rsrc((void*)(ws + (dir ? WS_OB : WS_OF)), 0, (int)((size_t)M * 1024 * 2), 0x00020000);
        if (!pre) { const float* wgp = (dir ? a->wg_b : a->wg_f) + (size_t)l * GRANK * 512 + h * GDK + lane;
#pragma unroll
            for (int r = 0; r < GRANK; ++r) wgn[r] = wgp[r * 512];
            bgn = (dir ? a->bg_b : a->bg_f)[l * 512 + h * GDK + lane]; }
        s16x4 whi[GRANK / 4], wlo[GRANK / 4];
#pragma unroll
        for (int kk = 0; kk < GRANK / 4; ++kk) { float wv[4], wl[4]; u32x2 ph, pl;
#pragma unroll
            for (int q = 0; q < 4; ++q) wv[q] = wgn[4 * kk + q];
            ph.x = cvt_pk_bf16(wv[0], wv[1]); ph.y = cvt_pk_bf16(wv[2], wv[3]);
            wl[0] = wv[0] - bflo(ph.x); wl[1] = wv[1] - bfhi(ph.x); wl[2] = wv[2] - bflo(ph.y); wl[3] = wv[3] - bfhi(ph.y);
            pl.x = cvt_pk_bf16(wl[0], wl[1]); pl.y = cvt_pk_bf16(wl[2], wl[3]);
            whi[kk] = __builtin_bit_cast(s16x4, ph); wlo[kk] = __builtin_bit_cast(s16x4, pl); }
        const float bg = bgn;
        f32x16 sacc;
        if (lat) { const float* sp = (dir ? a->st_b : a->st_f) + (((size_t)b * DEPTH + l) * GH + h) * GDK * GDV + (size_t)(32 * std_ + 4 * hi) * GDV + 32 * ste + r32;
#pragma unroll
            for (int r = 0; r < 16; ++r) sacc[r] = sp[(size_t)((r & 3) + 8 * (r >> 2)) * GDV]; }
        else {
#pragma unroll
            for (int r = 0; r < 16; ++r) sacc[r] = 0.f; }
#pragma unroll
        for (int q = 0; q < 4; ++q) { u32x2 w; w.x = cvt_pk_bf16(sacc[4 * q], sacc[4 * q + 1]); w.y = cvt_pk_bf16(sacc[4 * q + 2], sacc[4 * q + 3]);
            *(LAS u32x2*)(ST + (32 * ste + r32) * GL_LD + 32 * std_ + 8 * q + 4 * hi) = w; }
        const __amdgpu_buffer_rsrc_t prsrc = __builtin_amdgcn_make_buffer_rsrc((void*)PROJ, 0, (int)((size_t)M * PROJ_P * 2), 0x00020000);
        const int voff_r = (dir ? 63 - gi_r : gi_r) * (PROJ_P * 2) + ((dir ? C_RB : C_RF) + (tid & 7) * 2) * 2;
        const int voff_v = (C_QG + h * 256 + 128 + 2 * lane) * 2, voff_q = (C_QG + h * 256 + (lane & ~1)) * 2, voff_k = (C_QG + h * 256 + 64 + (lane & ~1)) * 2;
#define GLA_LOADS(S_, c_, rb_, dir_, T_, vr_, vv_, vq_, vk_) do { const int low_ = (rb_) + ((dir_) ? ((T_) - 64 - 64 * (c_)) : 64 * (c_)); \
            pr_r##S_ = __builtin_amdgcn_raw_buffer_load_b32(prsrc, (vr_), low_ * (PROJ_P * 2), 0); \
            _Pragma("unroll") for (int tt = 0; tt < 8; ++tt) { const int so_ = (low_ + ((dir_) ? 63 - (8 * wave + tt) : (8 * wave + tt))) * (PROJ_P * 2); \
                pr_v##S_[tt] = __builtin_amdgcn_raw_buffer_load_b32(prsrc, (vv_), so_, 0); pr_q##S_[tt] = __builtin_amdgcn_raw_buffer_load_b32(prsrc, (vq_), so_, 0); pr_k##S_[tt] = __builtin_amdgcn_raw_buffer_load_b32(prsrc, (vk_), so_, 0); } } while (0)
#define GLA_LOADV(S_, v_) do { if ((v_) < nch) GLA_LOADS(S_, (v_), row_base, dir, T, voff_r, voff_v, voff_q, voff_k); \
            else if (mode == 1) { \
                if ((v_) == nch) { it_next = N_GLA_LAT + (int)*slot; nv = it_next < N_GLA_LAT + N_GLA_CTX;        \
                    if (nv) { const int un = it_next - N_GLA_LAT; dirn = un & 1; hn = (un >> 1) % GH; rbn = (un / (2 * GH)) * S_CTX; \
                        vrn = (dirn ? 63 - gi_r : gi_r) * (PROJ_P * 2) + ((dirn ? C_RB : C_RF) + (tid & 7) * 2) * 2; \
                        vvn = (C_QG + hn * 256 + 128 + 2 * lane) * 2; vqn = (C_QG + hn * 256 + (lane & ~1)) * 2; vkn = (C_QG + hn * 256 + 64 + (lane & ~1)) * 2; } } \
                if (nv) GLA_LOADS(S_, (v_) - nch, rbn, dirn, S_CTX, vrn, vvn, vqn, vkn); } } while (0)
#define GLA_STAGES(S_, par_) do { ((LAS unsigned*)RR)[gi_r * 8 + (tid & 7)] = pr_r##S_; \
            { u32x4 lo, hi4; LAS bf16_t* vt_ = VT + (par_) * (128 * GL_LD); \
              lo.x = __builtin_amdgcn_perm(pr_v##S_[1], pr_v##S_[0], 0x05040100u); lo.y = __builtin_amdgcn_perm(pr_v##S_[3], pr_v##S_[2], 0x05040100u); lo.z = __builtin_amdgcn_perm(pr_v##S_[5], pr_v##S_[4], 0x05040100u); lo.w = __builtin_amdgcn_perm(pr_v##S_[7], pr_v##S_[6], 0x05040100u); \
              hi4.x = __builtin_amdgcn_perm(pr_v##S_[1], pr_v##S_[0], 0x07060302u); hi4.y = __builtin_amdgcn_perm(pr_v##S_[3], pr_v##S_[2], 0x07060302u); hi4.z = __builtin_amdgcn_perm(pr_v##S_[5], pr_v##S_[4], 0x07060302u); hi4.w = __builtin_amdgcn_perm(pr_v##S_[7], pr_v##S_[6], 0x07060302u); \
              *(LAS u32x4*)(vt_ + (2 * lane) * GL_LD + 8 * wave) = lo; *(LAS u32x4*)(vt_ + (2 * lane + 1) * GL_LD + 8 * wave) = hi4; } \
            _Pragma("unroll") for (int tt = 0; tt < 8; ++tt) { qv[tt] = __uint_as_float((pr_q##S_[tt] >> qksh) << 16); kv[tt] = __uint_as_float((pr_k##S_[tt] >> qksh) << 16); } } while (0)
        int dirn = 0, rbn = 0, vrn = 0, vvn = 0, vqn = 0, vkn = 0, hn = 0; bool nv = false;
        if (!pre) { GLA_LOADS(0, 0, row_base, dir, T, voff_r, voff_v, voff_q, voff_k); GLA_STAGES(0, 0);
            GLA_LOADS(1, 1, row_base, dir, T, voff_r, voff_v, voff_q, voff_k); GLA_LOADS(0, 2, row_base, dir, T, voff_r, voff_v, voff_q, voff_k); }
        pre = false;
        for (int c2 = 0; c2 < nch; c2 += 2) {
#pragma unroll
          for (int par = 0; par < 2; ++par) { const int c = c2 + par;
            const int low = row_base + (dir ? (T - 64 - 64 * c) : 64 * c);
            const LAS bf16_t* VTc = VT + par * (128 * GL_LD);
            __syncthreads();
            float bl[8]; float run = 0.f;
            f32x4 zz[2];
#pragma unroll
            for (int g = 0; g < 2; ++g) { const LAS u32x4* rp = (const LAS u32x4*)((const LAS unsigned*)RR + (8 * wave + 4 * g + (lane & 3)) * 8);
                const u32x4 r0 = rp[0], r1 = rp[1];
                const s16x4 a0 = __builtin_bit_cast(s16x4, (u32x2){r0.x, r0.y}), a1 = __builtin_bit_cast(s16x4, (u32x2){r0.z, r0.w}), a2 = __builtin_bit_cast(s16x4, (u32x2){r1.x, r1.y}), a3 = __builtin_bit_cast(s16x4, (u32x2){r1.z, r1.w});
                f32x4 acc = (f32x4){bg, bg, bg, bg};
                acc = __builtin_amdgcn_mfma_f32_4x4x4bf16_1k(a0, whi[0], acc, 0, 0, 0); acc = __builtin_amdgcn_mfma_f32_4x4x4bf16_1k(a1, whi[1], acc, 0, 0, 0);
                acc = __builtin_amdgcn_mfma_f32_4x4x4bf16_1k(a2, whi[2], acc, 0, 0, 0); acc = __builtin_amdgcn_mfma_f32_4x4x4bf16_1k(a3, whi[3], acc, 0, 0, 0);
                acc = __builtin_amdgcn_mfma_f32_4x4x4bf16_1k(a0, wlo[0], acc, 0, 0, 0); acc = __builtin_amdgcn_mfma_f32_4x4x4bf16_1k(a1, wlo[1], acc, 0, 0, 0);
                acc = __builtin_amdgcn_mfma_f32_4x4x4bf16_1k(a2, wlo[2], acc, 0, 0, 0); acc = __builtin_amdgcn_mfma_f32_4x4x4bf16_1k(a3, wlo[3], acc, 0, 0, 0);
                zz[g] = acc; }
#pragma unroll
            for (int tt = 0; tt < 8; ++tt) {
                const float z = zz[tt >> 2][tt & 3];
                const float l2 = __builtin_amdgcn_logf(1.0f + __builtin_amdgcn_exp2f(-1.4426950408889634f * fabsf(z)));
                run += fminf(z, 0.f) * (1.4426950408889634f / 16.0f) - l2 * (1.0f / 16.0f); bl[tt] = run; }
            TOT[wave * 64 + lane] = run;
            __syncthreads();
            float pre = 0.f, blast = 0.f;
#pragma unroll
            for (int w2 = 0; w2 < 8; ++w2) { const float tv = TOT[w2 * 64 + lane]; blast += tv; if (w2 < wave) pre += tv; }
            float kh[8];
            const float eblast = __builtin_amdgcn_exp2f(blast);
#pragma unroll
            for (int tt = 0; tt < 8; ++tt) { const int i = 8 * wave + tt; const float eb = __builtin_amdgcn_exp2f(pre + bl[tt]), kd = kv[tt] * __builtin_amdgcn_rcpf(eb);
                QT[i * GL_LD + lane] = bf1(qv[tt] * 0.125f * eb);
                KT[i * GL_LD + lane] = bf1(kd);
                kh[tt] = kd * eblast; }
            { u32x4 w; w.x = cvt_pk_bf16(kh[0], kh[1]); w.y = cvt_pk_bf16(kh[2], kh[3]); w.z = cvt_pk_bf16(kh[4], kh[5]); w.w = cvt_pk_bf16(kh[6], kh[7]);
              *(LAS u32x4*)(KH + lane * GL_LD + 8 * wave) = w; }
            if (wave == 0) DL[lane] = eblast;
            __syncthreads();
            f32x16 oacc;
#pragma unroll
            for (int r = 0; r < 16; ++r) oacc[r] = 0.f;
#pragma unroll
            for (int ks = 0; ks < 4; ++ks) { const bf16x8 af = *(const LAS bf16x8*)(QT + (32 * oti + r32) * GL_LD + 16 * ks + 8 * hi);
                const bf16x8 bfr = *(const LAS bf16x8*)(ST + (32 * ote + r32) * GL_LD + 16 * ks + 8 * hi);
                oacc = __builtin_amdgcn_mfma_f32_32x32x16_bf16(bfr, af, oacc, 0, 0, 0); }
            if (wave < 4) { const int si = wave >> 1, sj = wave & 1;
                f32x16 p;
#pragma unroll
                for (int r = 0; r < 16; ++r) p[r] = 0.f;
                if (wave != 1) {
#pragma unroll
                    for (int ks = 0; ks < 4; ++ks) { const bf16x8 af = *(const LAS bf16x8*)(QT + (32 * si + r32) * GL_LD + 16 * ks + 8 * hi);
                        const bf16x8 bfr = *(const LAS bf16x8*)(KT + (32 * sj + r32) * GL_LD + 16 * ks + 8 * hi);
                        p = __builtin_amdgcn_mfma_f32_32x32x16_bf16(bfr, af, p, 0, 0, 0); } }
#pragma unroll
                for (int q = 0; q < 4; ++q) { const int i = 32 * si + r32, j0 = 32 * sj + 8 * q + 4 * hi; u32x2 w;
                    w.x = cvt_pk_bf16(j0 <= i ? p[4 * q] : 0.f, j0 + 1 <= i ? p[4 * q + 1] : 0.f); w.y = cvt_pk_bf16(j0 + 2 <= i ? p[4 * q + 2] : 0.f, j0 + 3 <= i ? p[4 * q + 3] : 0.f);
                    *(LAS u32x2*)(PP + i * GL_LD + j0) = w; } }
            __syncthreads();
#pragma unroll
            for (int ks = 0; ks < 4; ++ks) { const bf16x8 af = *(const LAS bf16x8*)(PP + (32 * oti + r32) * GL_LD + 16 * ks + 8 * hi);
                const bf16x8 bfr = *(const LAS bf16x8*)(VTc + (32 * ote + r32) * GL_LD + 16 * ks + 8 * hi);
                oacc = __builtin_amdgcn_mfma_f32_32x32x16_bf16(bfr, af, oacc, 0, 0, 0); }
#pragma unroll
            for (int q = 0; q < 4; ++q) { const int i = 32 * oti + r32; u32x2 w; w.x = cvt_pk_bf16(oacc[4 * q], oacc[4 * q + 1]); w.y = cvt_pk_bf16(oacc[4 * q + 2], oacc[4 * q + 3]);
                __builtin_amdgcn_raw_buffer_store_b64(w, orsrc, (dir ? 63 - i : i) * 2048 + (h * GDV + 32 * ote + 8 * q + 4 * hi) * 2, low * 2048, 0); }
#pragma unroll
            for (int q = 0; q < 4; ++q) { const f32x4 dl = *(const LAS f32x4*)(DL + 32 * std_ + 8 * q + 4 * hi);
                sacc[4 * q] *= dl[0]; sacc[4 * q + 1] *= dl[1]; sacc[4 * q + 2] *= dl[2]; sacc[4 * q + 3] *= dl[3]; }
#pragma unroll
            for (int ks = 0; ks < 4; ++ks) { const bf16x8 af = *(const LAS bf16x8*)(VTc + (32 * ste + r32) * GL_LD + 16 * ks + 8 * hi);
                const bf16x8 bfr = *(const LAS bf16x8*)(KH + (32 * std_ + r32) * GL_LD + 16 * ks + 8 * hi);
                sacc = __builtin_amdgcn_mfma_f32_32x32x16_bf16(bfr, af, sacc, 0, 0, 0); }
#pragma unroll
            for (int q = 0; q < 4; ++q) { u32x2 w; w.x = cvt_pk_bf16(sacc[4 * q], sacc[4 * q + 1]); w.y = cvt_pk_bf16(sacc[4 * q + 2], sacc[4 * q + 3]);
                *(LAS u32x2*)(ST + (32 * ste + r32) * GL_LD + 32 * std_ + 8 * q + 4 * hi) = w; }
            if (c + 1 < nch || (mode == 1 && nv)) {
                if (par == 0) GLA_STAGES(1, 1); else GLA_STAGES(0, 0);
                if (c + 1 == nch) { const float* wgp = (dirn ? a->wg_b : a->wg_f) + (size_t)l * GRANK * 512 + hn * GDK + lane;
#pragma unroll
                    for (int r = 0; r < GRANK; ++r) wgn[r] = wgp[r * 512];
                    bgn = (dirn ? a->bg_b : a->bg_f)[l * 512 + hn * GDK + lane];
                    pre = true; } }
            if (par == 0) GLA_LOADV(1, c + 3); else GLA_LOADV(0, c + 3);
            if (c == 0 && mode == 1 && tid == 0) *slot = nxt_v;
          }
        }
#undef GLA_LOADS
#undef GLA_LOADV
#undef GLA_STAGES
        if (!lat) { float* so = a->out + (dir ? OUT_SB : OUT_SF) + (((size_t)b * DEPTH + l) * GH + h) * GDK * GDV + (size_t)(32 * std_ + 4 * hi) * GDV + 32 * ste + r32;
#pragma unroll
            for (int r = 0; r < 16; ++r) so[(size_t)((r & 3) + 8 * (r >> 2)) * GDV] = sacc[r]; }
    }
}

__device__ __forceinline__ void phase_glafin(KArgsP a, int l, int G) {
    const int tid = tid_fresh(), lane = tid & 63, wave = __builtin_amdgcn_readfirstlane(tid >> 6);
    unsigned char* ws = a->ws;
    const bf16_t* OF = (const bf16_t*)(ws + WS_OF); const bf16_t* OB = (const bf16_t*)(ws + WS_OB);
    const bf16_t* PROJ = (const bf16_t*)(ws + WS_PROJ); bf16_t* MIXA = (bf16_t*)(ws + WS_MIXA);
    const int gw = blockIdx.x * 8 + wave, NGW = G * 8;
    constexpr int RB = 3;
    f32x4 gn[2]; { const float* gp = a->gla_norm + l * GDV + ((8 * lane) & 127); gn[0] = *(const f32x4*)gp; gn[1] = *(const f32x4*)(gp + 4); }
    for (int row = gw * RB; row < M; row += NGW * RB) {
        u32x4 wf[RB][2], wb[RB][2], wo[RB][2];
#pragma unroll
        for (int rr = 0; rr < RB; ++rr)
#pragma unroll
            for (int j = 0; j < 2; ++j) { const int c = 512 * j + 8 * lane; const size_t r = row + rr;
                wf[rr][j] = __builtin_nontemporal_load((const u32x4*)(OF + r * 1024 + c)); wb[rr][j] = __builtin_nontemporal_load((const u32x4*)(OB + r * 1024 + c)); wo[rr][j] = __builtin_nontemporal_load((const u32x4*)(PROJ + r * PROJ_P + C_OG + c)); }
#pragma unroll
        for (int rr = 0; rr < RB; ++rr)
#pragma unroll
            for (int j = 0; j < 2; ++j) { const u32x4 f = wf[rr][j], b = wb[rr][j], g = wo[rr][j];
                float o[8] = {bflo(f.x) + bflo(b.x), bfhi(f.x) + bfhi(b.x), bflo(f.y) + bflo(b.y), bfhi(f.y) + bfhi(b.y), bflo(f.z) + bflo(b.z), bfhi(f.z) + bfhi(b.z), bflo(f.w) + bflo(b.w), bfhi(f.w) + bfhi(b.w)};
                const float og[8] = {bflo(g.x), bfhi(g.x), bflo(g.y), bfhi(g.y), bflo(g.z), bfhi(g.z), bflo(g.w), bfhi(g.w)};
                float ss = 0.f;
#pragma unroll
                for (int e = 0; e < 8; ++e) ss += o[e] * o[e];
                ss += __shfl_xor(ss, 1); ss += __shfl_xor(ss, 2); ss += __shfl_xor(ss, 4); ss += __shfl_xor(ss, 8);
                const float rstd = 1.0f / sqrtf(ss * (1.0f / GDV) + EPS);
                float y[8];
#pragma unroll
                for (int e = 0; e < 8; ++e) y[e] = o[e] * rstd * gn[e >> 2][e & 3] * silu_f(og[e]);
                u32x4 w; w.x = cvt_pk_bf16(y[0], y[1]); w.y = cvt_pk_bf16(y[2], y[3]); w.z = cvt_pk_bf16(y[4], y[5]); w.w = cvt_pk_bf16(y[6], y[7]);
                *(u32x4*)(MIXA + (size_t)(row + rr) * DM + 1024 + 512 * j + 8 * lane) = w; }
    }
}

constexpr int PH_PER_LAYER = 9, N_PHASES = 2 + DEPTH * PH_PER_LAYER;
__global__ void __launch_bounds__(512, 2) hybrid_fwd(Args args) {
    extern __shared__ __attribute__((aligned(16))) unsigned char lds_raw[];
    LAS unsigned char* lds = (LAS unsigned char*)lds_raw;
    volatile LAS unsigned* MISC = (volatile LAS unsigned*)(lds + MISC_OFF);
    const int tid = threadIdx.x, G = gridDim.x;
    KArgsP ka0 = ka_get();
    unsigned char* ws = ka0->ws;
    gu32* ctl = (gu32*)(ws + WS_CTL);
    for (int u = tid; u < (LDS_BYTES - RING_BYTES) / 4; u += 512) ((LAS unsigned*)(lds + RING_BYTES))[u] = 0u;
    __syncthreads();
#if MK_PER_PHASE
#define GRID_BAR() do { } while (0)
#else
    XcdBarrier bar = xcd_barrier_post((unsigned*)(ctl + CW_BAR), MISC + 8);
#define GRID_BAR() xcd_barrier(bar)
#endif
    const int lo = ka0->ph_lo, hi = ka0->ph_hi;
#define IN(k) (lo <= (k) && (k) < hi)
#ifndef MK_DUPBAR
#define MK_DUPBAR 0
#endif
#define SEAM(k) do { if (IN(k) && IN((k) + 1)) { GRID_BAR(); if (MK_DUPBAR) GRID_BAR(); } } while (0)
    bf16_t* XB = (bf16_t*)(ws + WS_XB);
    const float* MOD = (const float*)(ws + WS_MOD);
    bf16_t* H = (bf16_t*)(ws + WS_H); bf16_t* PROJ = (bf16_t*)(ws + WS_PROJ); bf16_t* MIXA = (bf16_t*)(ws + WS_MIXA); bf16_t* HID = (bf16_t*)(ws + WS_HID);

    if (HAS(0) && IN(0)) { for (int rep = 0; rep < DUP(0); ++rep) { if (MK_DUPSYNC && rep) GRID_BAR(); phase_prologue(ka_get(), lds, G); __syncthreads(); } } SEAM(0);

    for (int l = 0; l < DEPTH; ++l) {
        const int p0 = 1 + l * PH_PER_LAYER;
        const float* mod_l = MOD + (size_t)l * NGRP * (6 * DM);

        if (HAS(1) && IN(p0 + 0)) for (int rep = 0; rep < DUP(1); ++rep) { if (MK_DUPSYNC && rep) GRID_BAR();
            phase_norm(XB, (l == 0 || rep) ? nullptr : (const bf16_t*)(ws + WS_SIDE), ka_get()->norm1 + l * DM, mod_l, 0 * DM, 1 * DM, H, G, l == 0 && rep == 0); } SEAM(p0 + 0);
        for (int sub = 0; sub < 2; ++sub) {
            if (HAS(2) && IN(p0 + 1 + sub)) for (int rep = 0; rep < DUP(10 + sub); ++rep) { if (MK_DUPSYNC && rep) GRID_BAR(); constexpr int NU = (M / 256) * (PROJ_P / 256), NA3 = 3 * 256;
                pg8::Gemm g{H, (const bf16_t*)(ws + WS_WIN) + (size_t)l * PROJ_P * DM, M, PROJ_P, DM}; pg8::InOrder S; S.init(G, (int)blockIdx.x, sub ? NA3 : 0, sub ? NU : NA3);
                KArgsP ka = ka_get(); pg8::EpiIn E{PROJ, ws, ka->out, ka->k_norm + l * HD, (LAS float*)(lds + RING_BYTES + 2048), l}; pg8::gemm_phase<pg8::EpiIn, pg8::InOrder, true, true>(lds, g, S, E);
                if (sub == 1 && HAS(4) && NA3 + (int)blockIdx.x >= NU) { __syncthreads(); phase_attn(ka_get(), l, (char*)lds_raw, ctl + CW_Q + 64 * (3 * l), MISC + 16, 0, 1); __syncthreads(); } }
            SEAM(p0 + 1 + sub); }


        if (IN(p0 + 3)) for (int rep = 0; rep < ((DUP(4) == 2 || DUP(5) == 2) ? 2 : 1); ++rep) { if (MK_DUPSYNC && rep) GRID_BAR();
            for (int pass = 0; pass < 2; ++pass) {
                if (HAS(5)) { phase_gla(ka_get(), l, lds, ctl + CW_Q + 64 * (3 * l + 1 + 16 * rep), MISC + 17, pass, G); __syncthreads(); }
                if (MK_PROBE_GLALAT && pass == 0) { GRID_BAR(); phase_gla(ka_get(), l, lds, ctl + CW_Q + 64 * (3 * l + 1 + 16 * rep), MISC + 17, 0, G); __syncthreads(); GRID_BAR(); }
                if (HAS(4)) { phase_attn(ka_get(), l, (char*)lds_raw, ctl + CW_Q + 64 * (3 * l + 2 * pass + 16 * rep), MISC + 16, pass, 1 << 30); __syncthreads(); } } } SEAM(p0 + 3);
        if (HAS(6) && IN(p0 + 4)) for (int rep = 0; rep < DUP(6); ++rep) { if (MK_DUPSYNC && rep) GRID_BAR(); phase_glafin(ka_get(), l, G); } SEAM(p0 + 4);
        if (HAS(7) && IN(p0 + 5)) for (int rep = 0; rep < DUP(7); ++rep) { if (MK_DUPSYNC && rep) GRID_BAR(); pg8::Gemm g{MIXA, (const bf16_t*)(ws + WS_WOUT) + (size_t)l * DM * DM, M, DM, DM}; pg8::SplitLatOrder S; S.init(DM, G, (int)blockIdx.x, WG_SPL);
            pg8::EpiResid E{XB, mod_l + 2 * DM, (bf16_t*)(ws + WS_SIDE), (DUP(7) == 2 && rep == 0) ? (lo >= 0) : 0}; pg8::gemm_phase<pg8::EpiResid, pg8::SplitLatOrder, true, true>(lds, g, S, E); } SEAM(p0 + 5);
        if (HAS(1) && IN(p0 + 6)) for (int rep = 0; rep < DUP(1); ++rep) { if (MK_DUPSYNC && rep) GRID_BAR(); phase_norm(XB, rep ? nullptr : (const bf16_t*)(ws + WS_SIDE), ka_get()->norm2 + l * DM, mod_l, 3 * DM, 4 * DM, H, G); } SEAM(p0 + 6);
        if (HAS(8) && IN(p0 + 7)) for (int rep = 0; rep < DUP(8); ++rep) { if (MK_DUPSYNC && rep) GRID_BAR(); pg8::Gemm g{H, (const bf16_t*)(ws + WS_WUP) + (size_t)l * DFF * DM, M, DFF, DM}; pg8::StaticOrder S; S.init(M, DFF, G, (int)blockIdx.x, DM, WG_UP);
            pg8::EpiBf16<1> E{HID, DFF}; pg8::gemm_phase<pg8::EpiBf16<1>, pg8::StaticOrder, true, true>(lds, g, S, E); } SEAM(p0 + 7);
        if (HAS(9) && IN(p0 + 8)) for (int rep = 0; rep < DUP(9); ++rep) { if (MK_DUPSYNC && rep) GRID_BAR(); pg8::Gemm g{HID, (const bf16_t*)(ws + WS_WDN) + (size_t)l * DM * DFF, M, DM, DFF}; pg8::SplitLatOrder S; S.init(DFF, G, (int)blockIdx.x, WG_SPL);
            pg8::EpiResid E{XB, mod_l + 5 * DM, (bf16_t*)(ws + WS_SIDE), (DUP(9) == 2 && rep == 0) ? (lo >= 0) : ((l == DEPTH - 1) ? 2 : 0)}; pg8::gemm_phase<pg8::EpiResid, pg8::SplitLatOrder, true, true>(lds, g, S, E); } SEAM(p0 + 8);
    }
    if (IN(N_PHASES - 1)) { const int t2 = tid_fresh(); float* Y = ka_get()->out + OUT_Y; const bf16_t* sd = (const bf16_t*)(ws + WS_SIDE);
        for (size_t i = (size_t)M_CTX * DM / 8 + (size_t)blockIdx.x * 512 + t2; i < (size_t)M * DM / 8; i += (size_t)G * 512) { const u32x4 w = __builtin_nontemporal_load((const u32x4*)(XB + i * 8));
            f32x4 a = (f32x4){bflo(w.x), bfhi(w.x), bflo(w.y), bfhi(w.y)}, b = (f32x4){bflo(w.z), bfhi(w.z), bflo(w.w), bfhi(w.w)};
            if (i >= (size_t)M_CTX * DM / 8) { const u32x4 v = __builtin_nontemporal_load((const u32x4*)(sd + (i - (size_t)M_CTX * DM / 8) * 8));
                a += (f32x4){bflo(v.x), bfhi(v.x), bflo(v.y), bfhi(v.y)}; b += (f32x4){bflo(v.z), bfhi(v.z), bflo(v.w), bfhi(v.w)}; }
            __builtin_nontemporal_store(a, (f32x4*)(Y + i * 8)); __builtin_nontemporal_store(b, (f32x4*)(Y + i * 8 + 4)); } }
#undef IN
#undef SEAM
}

extern "C" void kernel_launch(void* const* d_in, const int* in_sizes, int n_in, void* d_out, int out_size, void* d_ws, size_t ws_size, hipStream_t stream) {
    static int grid = 0;
    if (grid == 0) {
        if (n_in != 23 || (size_t)out_size != OUT_END || ws_size < WS_END) { fprintf(stderr, "kernel_launch: unexpected shapes (n_in %d out %d ws %zu)\n", n_in, out_size, ws_size); grid = -1; return; }
        int dev = 0, cus = 0, per_cu = 0;
        if (hipGetDevice(&dev) != hipSuccess || hipDeviceGetAttribute(&cus, hipDeviceAttributeMultiprocessorCount, dev) != hipSuccess) { grid = -1; return; }
        if (hipFuncSetAttribute((const void*)hybrid_fwd, hipFuncAttributeMaxDynamicSharedMemorySize, LDS_BYTES) != hipSuccess) { fprintf(stderr, "kernel_launch: hipFuncSetAttribute failed\n"); grid = -1; return; }
        if (hipOccupancyMaxActiveBlocksPerMultiprocessor(&per_cu, (const void*)hybrid_fwd, 512, LDS_BYTES) != hipSuccess || per_cu < 1) { fprintf(stderr, "kernel_launch: occupancy query says %d\n", per_cu); }
        (void)hipGetLastError();
        grid = cus;
    }
    if (grid < 0) return;
    if (hipMemsetAsync((char*)d_ws + WS_CTL, 0, CTL_ZERO_BYTES, stream) != hipSuccess) return;
    Args a{};
    a.x_prompt = (const float*)d_in[0]; a.x_sample = (const float*)d_in[1]; a.cache_k = (const float*)d_in[2]; a.cache_v = (const float*)d_in[3];
    a.st_f = (const float*)d_in[4]; a.st_b = (const float*)d_in[5]; a.c = (const float*)d_in[6]; a.c_ctx = (const float*)d_in[7];
    a.w_mod = (const float*)d_in[8]; a.b_mod = (const float*)d_in[9]; a.norm1 = (const float*)d_in[10]; a.w_in = (const float*)d_in[11];
    a.q_norm = (const float*)d_in[12]; a.k_norm = (const float*)d_in[13]; a.wg_f = (const float*)d_in[14]; a.bg_f = (const float*)d_in[15];
    a.wg_b = (const float*)d_in[16]; a.bg_b = (const float*)d_in[17]; a.gla_norm = (const float*)d_in[18]; a.w_out = (const float*)d_in[19];
    a.norm2 = (const float*)d_in[20]; a.w_up = (const float*)d_in[21]; a.w_down = (const float*)d_in[22];
    a.out = (float*)d_out; a.ws = (unsigned char*)d_ws;
#if MK_PER_PHASE
    for (int p = 0; p < N_PHASES; ++p) { a.ph_lo = p; a.ph_hi = p + 1; hipLaunchKernelGGL(hybrid_fwd, dim3(grid), dim3(512), LDS_BYTES, stream, a); }
#else
    a.ph_lo = 0; a.ph_hi = N_PHASES;
    hipLaunchKernelGGL(hybrid_fwd, dim3(grid), dim3(512), LDS_BYTES, stream, a);
#endif
    const hipError_t le = hipPeekAtLastError();
    if (le != hipSuccess) fprintf(stderr, "kernel_launch: launch failed: %s\n", hipGetErrorName(le));
}
```
